# Optimizing an MI355X kernel written in HIP

```python
import jax, jax.numpy as jnp
from jax import lax
import numpy as np

D_MODEL = 1024
BATCH = 4
SEQ = 4096
DEPTH = 1

N_META = 16
GRID_W = 64
MIX_WIDTH = D_MODEL
NA_WIDTH = MIX_WIDTH // 2
NA_HEAD_DIM = 64
NA_HEADS = NA_WIDTH // NA_HEAD_DIM
NA_KH_MAX = 8
NA_KW = 16
HG_WIDTH = MIX_WIDTH - NA_WIDTH
HG_HEAD_DIM = 128
HG_HEADS = HG_WIDTH // HG_HEAD_DIM
HG_CHUNK = 64
IN_WIDTHS = [NA_WIDTH] * 3 + [HG_WIDTH] * 5
IN_COLS = sum(IN_WIDTHS)
N_EXPERTS = 32
TOP_K = 4
D_FF = D_MODEL
SWIGLU_LIMIT = 7.0
SWIGLU_ALPHA = 1.702
MOE_BLOCK = 128
RMS_EPS = 1e-6

kernel_name = "hymba_natten_hgrn2_moe_encoder"


def rms_norm(x, g):
    x32 = x.astype(jnp.float32)
    y = x32 * lax.rsqrt(jnp.mean(x32 * x32, axis=-1, keepdims=True) + RMS_EPS)
    return (y * g.astype(jnp.float32)).astype(x.dtype)


def head_rms_norm(y, g, n_heads):
    B, L, W = y.shape
    y32 = y.astype(jnp.float32).reshape(B, L, n_heads, W // n_heads)
    y32 = y32 * lax.rsqrt(jnp.mean(y32 * y32, axis=-1, keepdims=True) + RMS_EPS)
    return (y32.reshape(B, L, W) * g.astype(jnp.float32)).astype(y.dtype)


def neighbourhood_attention(q_raw, k_raw, v_raw, rpb):
    B, L, _ = q_raw.shape
    T = L - N_META
    ROWS = T // GRID_W
    KH = min(NA_KH_MAX, ROWS)
    H, dh = NA_HEADS, NA_HEAD_DIM
    scale = dh ** -0.5

    def heads(t):
        return t.reshape(B, L, H, dh).transpose(0, 2, 1, 3)

    q, k, v = heads(q_raw) * scale, heads(k_raw), heads(v_raw)
    qm, km, vm = q[:, :, :N_META], k[:, :, :N_META], v[:, :, :N_META]
    q_grid = q[:, :, N_META:].reshape(B, H, ROWS, GRID_W, dh)
    k_grid = k[:, :, N_META:].reshape(B, H, ROWS, GRID_W, dh)
    v_grid = v[:, :, N_META:].reshape(B, H, ROWS, GRID_W, dh)

    cols = np.arange(GRID_W)
    col_start = np.clip(cols - NA_KW // 2, 0, GRID_W - NA_KW)
    col_idx = col_start[:, None] + np.arange(NA_KW)[None, :]
    dc_idx = col_idx - cols[:, None] + (NA_KW - 1)
    rpb_cols = rpb.astype(jnp.float32)[:, :, dc_idx]

    def row_block(r):
        rs = jnp.clip(r - KH // 2, 0, ROWS - KH)
        qb = lax.dynamic_index_in_dim(q_grid, r, axis=2, keepdims=False)
        kb = lax.dynamic_slice_in_dim(k_grid, rs, KH, axis=2)[:, :, :, col_idx]
        vb = lax.dynamic_slice_in_dim(v_grid, rs, KH, axis=2)[:, :, :, col_idx]
        s_win = jnp.einsum('bhcd,bhicjd->bhcij', qb, kb).astype(jnp.float32)
        dr = rs - r + jnp.arange(KH) + (NA_KH_MAX - 1)
        bias = jnp.take(rpb_cols, dr, axis=1).transpose(0, 2, 1, 3)
        s_win = s_win + bias[None]
        s_meta = jnp.einsum('bhcd,bhmd->bhcm', qb, km).astype(jnp.float32)
        s = jnp.concatenate([s_win.reshape(B, H, GRID_W, KH * NA_KW), s_meta], axis=-1)
        p = jax.nn.softmax(s, axis=-1)
        p_win = p[..., :KH * NA_KW].reshape(B, H, GRID_W, KH, NA_KW)
        p_meta = p[..., KH * NA_KW:]
        return (jnp.einsum('bhcij,bhicjd->bhcd', p_win, vb.astype(jnp.float32))
                + jnp.einsum('bhcm,bhmd->bhcd', p_meta, vm.astype(jnp.float32)))

    o_rows = lax.map(row_block, jnp.arange(ROWS))
    o_real = o_rows.transpose(1, 2, 0, 3, 4).reshape(B, H, T, dh)
    p_mm = jax.nn.softmax(jnp.einsum('bhmd,bhnd->bhmn', qm, km).astype(jnp.float32), axis=-1)
    o_meta = jnp.einsum('bhmn,bhnd->bhmd', p_mm, vm.astype(jnp.float32))
    o = jnp.concatenate([o_meta, o_real], axis=2).transpose(0, 2, 1, 3)
    return o.reshape(B, L, NA_WIDTH).astype(q_raw.dtype)


def gla_chunk(S, q, k, v, g):
    C = q.shape[2]
    b = jnp.cumsum(g, axis=2)
    mask = jnp.tril(jnp.ones((C, C), dtype=bool))[:, :, None]
    diff = b[:, :, :, None, :] - b[:, :, None, :, :]
    decay = jnp.exp(jnp.where(mask, diff, -jnp.inf))
    attn = jnp.einsum('bhtk,bhtsk,bhsk->bhts', q, decay, k)
    o = (jnp.einsum('bhts,bhsv->bhtv', attn, v)
         + jnp.einsum('bhtk,bhkv->bhtv', q * jnp.exp(b), S))
    b_last = b[:, :, -1:, :]
    S_new = (jnp.exp(b_last[:, :, 0, :])[..., None] * S
             + jnp.einsum('bhsk,bhsv->bhkv', k * jnp.exp(b_last - b), v))
    return S_new, o


def gla_scan(q, k, v, g, reverse):
    B, H, L, dk = q.shape
    dv = v.shape[-1]
    T = L - N_META
    NC = T // HG_CHUNK

    def real(t):
        t = t[:, :, N_META:]
        return jnp.flip(t, axis=2) if reverse else t

    def to_chunks(t):
        return jnp.moveaxis(t.reshape(B, H, NC, HG_CHUNK, t.shape[-1]), 2, 0)

    S0 = jnp.zeros((B, H, dk, dv), jnp.float32)
    S, o_meta = gla_chunk(S0, q[:, :, :N_META], k[:, :, :N_META], v[:, :, :N_META], g[:, :, :N_META])

    def step(S, xs):
        return gla_chunk(S, *xs)

    _, o_real = lax.scan(step, S, (to_chunks(real(q)), to_chunks(real(k)),
                                   to_chunks(real(v)), to_chunks(real(g))))
    o_real = jnp.moveaxis(o_real, 0, 2).reshape(B, H, T, dv)
    if reverse:
        o_real = jnp.flip(o_real, axis=2)
    return jnp.concatenate([o_meta, o_real], axis=2)


def hgrn2_bidirectional(q_raw, i_raw, f_fwd_raw, f_bwd_raw, gate_raw, lb, g_norm):
    B, L, _ = q_raw.shape

    def heads(t):
        return t.reshape(B, L, HG_HEADS, HG_HEAD_DIM).transpose(0, 2, 1, 3)

    q = heads(jax.nn.silu(q_raw.astype(jnp.float32)))
    v = heads(i_raw.astype(jnp.float32))

    def gates(f_raw, lb_dir):
        f = lb_dir + (1.0 - lb_dir) * jax.nn.sigmoid(f_raw.astype(jnp.float32))
        return heads(1.0 - f), heads(jnp.log(f))

    k_f, g_f = gates(f_fwd_raw, lb[0])
    k_b, g_b = gates(f_bwd_raw, lb[1])
    o = gla_scan(q, k_f, v, g_f, reverse=False) + gla_scan(q, k_b, v, g_b, reverse=True)
    o = o.transpose(0, 2, 1, 3)
    o = o * lax.rsqrt(jnp.mean(o * o, axis=-1, keepdims=True) + RMS_EPS)
    o = o.reshape(B, L, HG_WIDTH) * g_norm.astype(jnp.float32)
    o = o * jax.nn.silu(gate_raw.astype(jnp.float32))
    return o.astype(q_raw.dtype)


def clamped_swiglu(gate, up):
    gate = jnp.minimum(gate, SWIGLU_LIMIT)
    up = jnp.clip(up, -SWIGLU_LIMIT, SWIGLU_LIMIT)
    return (up + 1.0) * gate * jax.nn.sigmoid(SWIGLU_ALPHA * gate)


def moe_ffn(x, router_w, router_b, w_gu, b_gu, w_down, b_down):
    B, L, D = x.shape
    xf = x.reshape(-1, D)
    N = xf.shape[0]
    NK = N * TOP_K
    logits = (xf @ router_w + router_b).astype(jnp.float32)
    top_vals, top_idx = lax.top_k(logits, TOP_K)
    top_w = jax.nn.softmax(top_vals, axis=-1)

    flat_e = top_idx.reshape(-1)
    flat_tok = jnp.arange(NK, dtype=jnp.int32) // TOP_K
    order = jnp.argsort(flat_e, stable=True)
    sorted_e = flat_e[order]
    sorted_tok = flat_tok[order]
    sorted_w = top_w.reshape(-1)[order]

    counts = jnp.bincount(flat_e, length=N_EXPERTS)
    padded = (counts + MOE_BLOCK - 1) // MOE_BLOCK * MOE_BLOCK
    pend = jnp.cumsum(padded)
    pstart = pend - padded
    start = jnp.cumsum(counts) - counts
    dest = pstart[sorted_e] + jnp.arange(NK, dtype=jnp.int32) - start[sorted_e]

    n_blocks = (NK + N_EXPERTS * (MOE_BLOCK - 1) + MOE_BLOCK - 1) // MOE_BLOCK
    x_buf = jnp.zeros((n_blocks * MOE_BLOCK, D), xf.dtype).at[dest].set(xf[sorted_tok])
    block_e = jnp.minimum(
        jnp.searchsorted(pend, jnp.arange(n_blocks, dtype=pend.dtype) * MOE_BLOCK, side='right'),
        N_EXPERTS - 1)

    def expert_block(args):
        xb, e = args
        gu = xb @ w_gu[e] + b_gu[e]
        act = clamped_swiglu(gu[:, :D_FF].astype(jnp.float32), gu[:, D_FF:].astype(jnp.float32))
        return act.astype(xb.dtype) @ w_down[e] + b_down[e]

    y_buf = lax.map(expert_block, (x_buf.reshape(n_blocks, MOE_BLOCK, D), block_e)).reshape(-1, D)
    y = jax.ops.segment_sum(y_buf[dest].astype(jnp.float32) * sorted_w[:, None], sorted_tok,
                            num_segments=N)
    return y.reshape(B, L, D).astype(x.dtype)


def setup_inputs(seed: int = 0) -> dict:
    key = jax.random.key(seed)
    ks = jax.random.split(key, 17)
    f32 = jnp.float32
    nrm = lambda k, shape, s: jax.random.normal(k, shape, f32) * s
    return {
        "x": nrm(ks[0], (BATCH, SEQ, D_MODEL), 1.0),
        "meta_tokens": nrm(ks[1], (N_META, D_MODEL), 1.0),
        "attn_norm_g": 1.0 + nrm(ks[2], (DEPTH, D_MODEL), 0.02),
        "w_in": nrm(ks[3], (DEPTH, D_MODEL, IN_COLS), D_MODEL ** -0.5),
        "na_rpb": nrm(ks[4], (DEPTH, NA_HEADS, 2 * NA_KH_MAX - 1, 2 * NA_KW - 1), 0.02),
        "na_norm_g": 1.0 + nrm(ks[5], (DEPTH, NA_WIDTH), 0.02),
        "hgrn_lb_logits": nrm(ks[6], (2, DEPTH + 1, HG_WIDTH), 0.5),
        "hgrn_norm_g": 1.0 + nrm(ks[7], (DEPTH, HG_WIDTH), 0.02),
        "w_out": nrm(ks[8], (DEPTH, MIX_WIDTH, D_MODEL), MIX_WIDTH ** -0.5),
        "ffn_norm_g": 1.0 + nrm(ks[9], (DEPTH, D_MODEL), 0.02),
        "router_w": nrm(ks[10], (DEPTH, D_MODEL, N_EXPERTS), D_MODEL ** -0.5),
        "router_b": nrm(ks[11], (DEPTH, N_EXPERTS), 0.01),
        "expert_w_gu": nrm(ks[12], (DEPTH, N_EXPERTS, D_MODEL, 2 * D_FF), D_MODEL ** -0.5),
        "expert_b_gu": nrm(ks[13], (DEPTH, N_EXPERTS, 2 * D_FF), 0.01),
        "expert_w_down": nrm(ks[14], (DEPTH, N_EXPERTS, D_FF, D_MODEL), D_FF ** -0.5),
        "expert_b_down": nrm(ks[15], (DEPTH, N_EXPERTS, D_MODEL), 0.01),
        "final_norm_g": 1.0 + nrm(ks[16], (D_MODEL,), 0.02),
    }


def reference(x, meta_tokens, attn_norm_g, w_in, na_rpb, na_norm_g, hgrn_lb_logits, hgrn_norm_g,
              w_out, ffn_norm_g, router_w, router_b, expert_w_gu, expert_b_gu, expert_w_down,
              expert_b_down, final_norm_g):
    B, T, D = x.shape
    meta = jnp.broadcast_to(meta_tokens.astype(x.dtype)[None], (B, N_META, D))
    h = jnp.concatenate([meta, x], axis=1)
    lower_bounds = jnp.cumsum(jax.nn.softmax(hgrn_lb_logits.astype(jnp.float32), axis=1), axis=1)
    split_at = [int(s) for s in np.cumsum(IN_WIDTHS)[:-1]]
    for l in range(DEPTH):
        n = rms_norm(h, attn_norm_g[l])
        proj = jnp.einsum('bld,de->ble', n, w_in[l])
        qa, ka, va, qh, ih, ff, fb, gh = jnp.split(proj, split_at, axis=-1)
        y_na = head_rms_norm(neighbourhood_attention(qa, ka, va, na_rpb[l]), na_norm_g[l], NA_HEADS)
        y_hg = hgrn2_bidirectional(qh, ih, ff, fb, gh, lower_bounds[:, l], hgrn_norm_g[l])
        mix = jnp.einsum('ble,ed->bld', jnp.concatenate([y_na, y_hg], axis=-1), w_out[l])
        h = h + mix.astype(h.dtype)
        h = h + moe_ffn(rms_norm(h, ffn_norm_g[l]), router_w[l], router_b[l], expert_w_gu[l],
                        expert_b_gu[l], expert_w_down[l], expert_b_down[l])
    return rms_norm(h[:, N_META:], final_norm_g)
```

```cpp
#include <hip/hip_runtime.h>
#include <cstdio>
#include <cstdint>

namespace pg8 {
#define PG8_LAS __attribute__((address_space(3)))
typedef unsigned short bf16_t;
typedef short bf16x8 __attribute__((ext_vector_type(8)));
typedef float f32x4 __attribute__((ext_vector_type(4)));
typedef unsigned u32x4 __attribute__((ext_vector_type(4)));
constexpr int BM = 256, BK = 64, HALF = 128, HTB = HALF * BK * 2  , STAGE_BYTES = 8 * HTB, NXCD = 8, WGM = 8;

__host__ __device__ __forceinline__ int lds_byte(int r, int c) { const int st = (r >> 4) * 2 + (c >> 5), rr = r & 15, cc = c & 31, ob = rr * 64 + cc * 2; return st * 1024 + (ob ^ (((ob >> 9) & 1) << 5)); }
__host__ __device__ __forceinline__ void stage_rc(int b, int& R, int& C) { const int st = b / 1024, sb = b % 1024, swz = sb ^ (((sb >> 9) & 1) << 5); R = (st >> 1) * 16 + swz / 64; C = (st & 1) * 32 + (swz % 64) / 2; }
__host__ __device__ __forceinline__ int perm32(int rho) { const int n = rho >> 4, i = rho & 15; return 8 * (i >> 2) + 4 * n + (i & 3); }

struct Unit { int pm, pn, pb, e; };
struct Gemm { const bf16_t* A; const bf16_t* Bt; int M, N, K; };

struct StaticOrder {
    int nM, nN, nwg, G, c;
    __host__ __device__ void init(int M, int N, int G_, int c_) { nM = M / BM; nN = N / BM; nwg = nM * nN; G = G_; c = c_; }
    __host__ __device__ bool next(int i, Unit& u) const {
        const long L = (long)i * G + c; if (L >= nwg) return false;
        int wgid = (int)L; { const int q = nwg / NXCD, r = nwg % NXCD, xcd = wgid % NXCD, off = wgid / NXCD; wgid = (xcd < r ? xcd * (q + 1) : r * (q + 1) + (xcd - r) * q) + off; }
        const int nig = WGM * nN, gid = wgid / nig, fm = gid * WGM, gsz = (nM - fm) < WGM ? (nM - fm) : WGM;
        u.pm = fm + ((wgid % nig) % gsz); u.pn = (wgid % nig) / gsz; u.pb = u.pn * BM; u.e = 0; return true;
    }
    __device__ __forceinline__ void a_ready(const Unit&) const {}
    __device__ __forceinline__ void done(const Unit&) const {}
};
struct MoeOrder {
    int nM, nN, nwg, G, c, NB; const PG8_LAS int* tile_e;
    __device__ void init(int nM_, int nN_, int G_, int c_, int NB_, const PG8_LAS int* te) { nM = nM_; nN = nN_; nwg = nM * nN; G = G_; c = c_; NB = NB_; tile_e = te; }
    __device__ bool next(int i, Unit& u) const {
        const long L = (long)i * G + c; if (L >= nwg) return false;
        int wgid = (int)L; { const int q = nwg / NXCD, r = nwg % NXCD, xcd = wgid % NXCD, off = wgid / NXCD; wgid = (xcd < r ? xcd * (q + 1) : r * (q + 1) + (xcd - r) * q) + off; }
        const int nig = WGM * nN, gid = wgid / nig, fm = gid * WGM, gsz = (nM - fm) < WGM ? (nM - fm) : WGM;
        u.pm = fm + ((wgid % nig) % gsz); u.pn = (wgid % nig) / gsz; u.e = tile_e[u.pm]; u.pb = u.e * NB + u.pn * BM; return true;
    }
    __device__ __forceinline__ void a_ready(const Unit&) const {}
    __device__ __forceinline__ void done(const Unit&) const {}
};

__device__ __forceinline__ unsigned cvt_pk_bf16(float lo, float hi) { unsigned r; asm volatile("v_cvt_pk_bf16_f32 %0, %1, %2" : "=v"(r) : "v"(lo), "v"(hi)); return r; }
__device__ __forceinline__ unsigned short cvt_bf16(float v) { return (unsigned short)(cvt_pk_bf16(v, v) & 0xffffu); }

struct EpiProj {
    static constexpr bool PERM = true, AFTER_DRAIN = false;
    bf16_t* P; bf16_t* VT;
    __device__ __forceinline__ void operator()(const f32x4 (&acc)[2][2][4][2], const Unit& u, int wr, int wc, int fr, int fq) const {
        const int row0 = u.pm * BM + wr * 64 + fr;
        if (u.pn == 4 || u.pn == 5) {
#pragma unroll
            for (int ai = 0; ai < 2; ++ai)
#pragma unroll
                for (int m = 0; m < 4; ++m) { const int row = row0 + ai * HALF + m * 16, b = row >> 12, t = row & 4095;
#pragma unroll
                    for (int bj = 0; bj < 2; ++bj)
#pragma unroll
                        for (int n = 0; n < 2; ++n)
#pragma unroll
                            for (int j = 0; j < 4; ++j) { const int cv = (u.pn - 4) * BM + bj * HALF + wc * 32 + 8 * fq + 4 * n + j;
                                VT[((size_t)(b * 512 + cv)) * 4096 + t] = cvt_bf16(acc[ai][bj][m][n][j]); } }
        } else {
            const int col0 = u.pn * BM + wc * 32 + 8 * fq;
#pragma unroll
            for (int ai = 0; ai < 2; ++ai)
#pragma unroll
                for (int m = 0; m < 4; ++m) { bf16_t* rowp = P + (size_t)(row0 + ai * HALF + m * 16) * 4096 + col0;
#pragma unroll
                    for (int bj = 0; bj < 2; ++bj) { const f32x4 v0 = acc[ai][bj][m][0], v1 = acc[ai][bj][m][1];
                        u32x4 w; w.x = cvt_pk_bf16(v0[0], v0[1]); w.y = cvt_pk_bf16(v0[2], v0[3]); w.z = cvt_pk_bf16(v1[0], v1[1]); w.w = cvt_pk_bf16(v1[2], v1[3]);
                        *(u32x4*)(rowp + bj * HALF) = w; } }
        }
    }
};
struct EpiResF32 {
    static constexpr bool PERM = false, AFTER_DRAIN = false;
    const float* base; float* out;
    __device__ __forceinline__ void operator()(const f32x4 (&acc)[2][2][4][2], const Unit& u, int wr, int wc, int fr, int fq) const {
        const int row0 = u.pm * BM + wr * 64 + fr, col0 = u.pn * BM + wc * 32 + 4 * fq;
#pragma unroll
        for (int ai = 0; ai < 2; ++ai)
#pragma unroll
            for (int m = 0; m < 4; ++m) { const size_t off = (size_t)(row0 + ai * HALF + m * 16) * 1024 + col0;
#pragma unroll
                for (int bj = 0; bj < 2; ++bj)
#pragma unroll
                    for (int n = 0; n < 2; ++n) { const f32x4 bs = *(const f32x4*)(base + off + bj * HALF + n * 16); *(f32x4*)(out + off + bj * HALF + n * 16) = bs + acc[ai][bj][m][n]; } }
    }
};
struct EpiSwiglu {
    static constexpr bool PERM = true, AFTER_DRAIN = false;
    bf16_t* act; const float* bgu;
    __device__ __forceinline__ void operator()(const f32x4 (&acc)[2][2][4][2], const Unit& u, int wr, int wc, int fr, int fq) const {
        const int row0 = u.pm * BM + wr * 64 + fr, c0 = u.pn * HALF + wc * 32 + 8 * fq;
        const float* bg = bgu + (size_t)u.e * 2048 + c0;
        f32x4 bgv[2], buv[2];
#pragma unroll
        for (int n = 0; n < 2; ++n) { bgv[n] = *(const f32x4*)(bg + 4 * n); buv[n] = *(const f32x4*)(bg + 1024 + 4 * n); }
#pragma unroll
        for (int ai = 0; ai < 2; ++ai)
#pragma unroll
            for (int m = 0; m < 4; ++m) { float r[8];
#pragma unroll
                for (int n = 0; n < 2; ++n)
#pragma unroll
                    for (int j = 0; j < 4; ++j) { float g = acc[ai][0][m][n][j] + bgv[n][j], up = acc[ai][1][m][n][j] + buv[n][j];
                        g = fminf(g, 7.0f); up = fminf(fmaxf(up, -7.0f), 7.0f);
                        const float sg = 1.0f / (1.0f + __expf(-1.702f * g)); r[4 * n + j] = (up + 1.0f) * g * sg; }
                u32x4 w; w.x = cvt_pk_bf16(r[0], r[1]); w.y = cvt_pk_bf16(r[2], r[3]); w.z = cvt_pk_bf16(r[4], r[5]); w.w = cvt_pk_bf16(r[6], r[7]);
                *(u32x4*)(act + (size_t)(row0 + ai * HALF + m * 16) * 1024 + c0) = w; }
    }
};
struct EpiDown {
    static constexpr bool PERM = true, AFTER_DRAIN = false;
    bf16_t* ys; const float* bd; const int* rowtok; const float* roww;
    __device__ __forceinline__ void operator()(const f32x4 (&acc)[2][2][4][2], const Unit& u, int wr, int wc, int fr, int fq) const {
        const int row0 = u.pm * BM + wr * 64 + fr, c0 = u.pn * BM + wc * 32 + 8 * fq;
        const float* b = bd + (size_t)u.e * 1024 + c0;
        f32x4 bv[2][2];
#pragma unroll
        for (int bj = 0; bj < 2; ++bj)
#pragma unroll
            for (int n = 0; n < 2; ++n) bv[bj][n] = *(const f32x4*)(b + bj * HALF + 4 * n);
#pragma unroll
        for (int ai = 0; ai < 2; ++ai)
#pragma unroll
            for (int m = 0; m < 4; ++m) { const int xr = row0 + ai * HALF + m * 16; const int tk = rowtok[xr]; const float w = roww[xr];
                if (tk >= 0) {
#pragma unroll
                    for (int bj = 0; bj < 2; ++bj) { const f32x4 v0 = (acc[ai][bj][m][0] + bv[bj][0]) * w, v1 = (acc[ai][bj][m][1] + bv[bj][1]) * w;
                        u32x4 o; o.x = cvt_pk_bf16(v0[0], v0[1]); o.y = cvt_pk_bf16(v0[2], v0[3]); o.z = cvt_pk_bf16(v1[0], v1[1]); o.w = cvt_pk_bf16(v1[2], v1[3]);
                        *(u32x4*)(ys + (size_t)tk * 1024 + c0 + bj * HALF) = o; } } }
    }
};

template <class Epi, class Sched, bool ALIGN_EPI = false, bool SP2 = false>
__device__ __forceinline__ void gemm_phase(PG8_LAS unsigned char* lds, const Gemm g, const Sched& S, const Epi& E) {
    const int tid = threadIdx.x, wid = __builtin_amdgcn_readfirstlane(tid >> 6), lane = tid & 63, wr = wid >> 2, wc = wid & 3, fr = lane & 15, fq = lane >> 4;
    const int K = g.K, nt = K / BK;
    unsigned voffA[2], voffB[2];
#pragma unroll
    for (int i = 0; i < 2; ++i) { int R, C; stage_rc(tid * 16 + i * 8192, R, C); const int Rb = Epi::PERM ? ((R & ~31) + perm32(R & 31)) : R;
        voffA[i] = (unsigned)(R * K + C) * 2u; voffB[i] = (unsigned)(Rb * K + C) * 2u; }
    const size_t kstep = (size_t)(BK * 2);
    const size_t hstep = (size_t)HALF * K * 2;
    const size_t tstep = 2 * hstep;
    const unsigned ldsw = (unsigned)wid * 1024u;
    const int aoff = lds_byte(wr * 64 + fr, fq * 8), boff = lds_byte(wc * 32 + fr, fq * 8);
#define PG8_SA(b, h) (((b) * 2 + (h)) * HTB)
#define PG8_SB(b, h) ((4 + (b) * 2 + (h)) * HTB)
#define PG8_STAGE(bufoff, gbase, voff) do { _Pragma("unroll") for (int _i = 0; _i < 2; ++_i) \
        __builtin_amdgcn_global_load_lds((const unsigned*)((const char*)(gbase) + (voff)[_i]), (PG8_LAS unsigned*)(lds + (bufoff) + ldsw + _i * 8192), 16, 0, 0); } while (0)
#define PG8_LDA(dst, b, h) do { _Pragma("unroll") for (int m = 0; m < 4; ++m) _Pragma("unroll") for (int k = 0; k < 2; ++k) dst[m][k] = *(const PG8_LAS bf16x8*)(lds + PG8_SA(b, h) + aoff + m * 2048 + k * 1024); } while (0)
#define PG8_LDB(dst, b, h) do { _Pragma("unroll") for (int n = 0; n < 2; ++n) _Pragma("unroll") for (int k = 0; k < 2; ++k) dst[n][k] = *(const PG8_LAS bf16x8*)(lds + PG8_SB(b, h) + boff + n * 2048 + k * 1024); } while (0)
#define PG8_MMA(ai, bj, At, Bt) do { __builtin_amdgcn_s_setprio(1); _Pragma("unroll") for (int m = 0; m < 4; ++m) _Pragma("unroll") for (int n = 0; n < 2; ++n) _Pragma("unroll") for (int k = 0; k < 2; ++k) \
        acc[ai][bj][m][n] = __builtin_amdgcn_mfma_f32_16x16x32_bf16(Bt[n][k], At[m][k], acc[ai][bj][m][n], 0, 0, 0); __builtin_amdgcn_s_setprio(0); } while (0)
#define PG8_WAIT_V(n) asm volatile("s_waitcnt vmcnt(" #n ")" ::: "memory")
#define PG8_WAIT_L(n) asm volatile("s_waitcnt lgkmcnt(" #n ")" ::: "memory")
#define PG8_BAR __builtin_amdgcn_s_barrier()
#define PG8_SCHED __builtin_amdgcn_sched_barrier(0)
    Unit cur, nxt; int ui = 0;
    if (!S.next(0, cur)) return;
    f32x4 acc[2][2][4][2];
#pragma unroll
    for (int a = 0; a < 2; ++a)
#pragma unroll
        for (int b = 0; b < 2; ++b)
#pragma unroll
            for (int m = 0; m < 4; ++m)
#pragma unroll
                for (int n = 0; n < 2; ++n) acc[a][b][m][n] = (f32x4){0.f, 0.f, 0.f, 0.f};
    bf16x8 At[4][2], B0[2][2], B1[2][2];
    const char* cA = (const char*)g.A + (size_t)cur.pm * tstep; const char* cB = (const char*)g.Bt + (size_t)cur.pb * (size_t)K * 2;
    S.a_ready(cur);
    if constexpr (SP2) {
        PG8_STAGE(PG8_SB(0, 0), cB, voffB); PG8_STAGE(PG8_SB(0, 1), cB + hstep, voffB); PG8_STAGE(PG8_SA(0, 0), cA, voffA); PG8_STAGE(PG8_SA(0, 1), cA + hstep, voffA);
        if (wr == 1) PG8_BAR;
        PG8_WAIT_V(2); PG8_BAR;
        PG8_STAGE(PG8_SB(1, 0), cB + kstep, voffB); PG8_STAGE(PG8_SA(1, 0), cA + kstep, voffA); PG8_STAGE(PG8_SB(1, 1), cB + hstep + kstep, voffB);
        PG8_WAIT_V(6); PG8_BAR;
    } else {
        PG8_STAGE(PG8_SB(0, 0), cB, voffB); PG8_STAGE(PG8_SA(0, 0), cA, voffA); PG8_STAGE(PG8_SB(0, 1), cB + hstep, voffB); PG8_STAGE(PG8_SA(0, 1), cA + hstep, voffA);
        if (wr == 1) PG8_BAR;
        PG8_WAIT_V(4); PG8_BAR;
        PG8_STAGE(PG8_SB(1, 0), cB + kstep, voffB); PG8_STAGE(PG8_SA(1, 0), cA + kstep, voffA); PG8_STAGE(PG8_SB(1, 1), cB + hstep + kstep, voffB);
        PG8_WAIT_V(6); PG8_BAR;
    }
    for (;;) {
        const bool has_next = S.next(ui + 1, nxt);
        const char* nA = has_next ? (const char*)g.A + (size_t)nxt.pm * tstep : cA; const char* nB = has_next ? (const char*)g.Bt + (size_t)nxt.pb * (size_t)K * 2 : cB;
        for (int t = 0; t < nt; t += 2) {
            const bool last = (t == nt - 2);
            const char* a1 = cA + (size_t)(t + 1) * kstep;
            const char* a2 = last ? nA : cA + (size_t)(t + 2) * kstep; const char* b2 = last ? nB : cB + (size_t)(t + 2) * kstep;
            const char* a3 = a2 + kstep; const char* b3 = b2 + kstep;
            if (last && has_next) S.a_ready(nxt);
            if constexpr (SP2) {
            PG8_LDB(B0, 0, 0); PG8_LDB(B1, 0, 1); PG8_SCHED; PG8_LDA(At, 0, 0); PG8_STAGE(PG8_SA(1, 1), a1 + hstep, voffA);
            PG8_WAIT_V(8); PG8_WAIT_L(0); PG8_BAR; PG8_MMA(0, 0, At, B0); PG8_MMA(0, 1, At, B1); PG8_BAR; PG8_SCHED;
            PG8_LDA(At, 0, 1); PG8_STAGE(PG8_SB(0, 0), b2, voffB); PG8_STAGE(PG8_SB(0, 1), b2 + hstep, voffB); PG8_STAGE(PG8_SA(0, 0), a2, voffA);
            PG8_WAIT_V(8); PG8_WAIT_L(0); PG8_BAR; PG8_MMA(1, 0, At, B0); PG8_MMA(1, 1, At, B1); PG8_BAR; PG8_SCHED;
            PG8_LDB(B0, 1, 0); PG8_LDB(B1, 1, 1); PG8_SCHED; PG8_LDA(At, 1, 0); PG8_STAGE(PG8_SA(0, 1), a2 + hstep, voffA);
            PG8_WAIT_V(8); PG8_WAIT_L(0); PG8_BAR; PG8_MMA(0, 0, At, B0); PG8_MMA(0, 1, At, B1); PG8_BAR; PG8_SCHED;
            PG8_LDA(At, 1, 1); PG8_STAGE(PG8_SB(1, 0), b3, voffB); PG8_STAGE(PG8_SB(1, 1), b3 + hstep, voffB); PG8_STAGE(PG8_SA(1, 0), a3, voffA);
            PG8_WAIT_V(8); PG8_WAIT_L(0); PG8_BAR; PG8_MMA(1, 0, At, B0); PG8_MMA(1, 1, At, B1); PG8_BAR; PG8_SCHED;
            } else {
            PG8_LDB(B0, 0, 0); PG8_SCHED; PG8_LDA(At, 0, 0); PG8_STAGE(PG8_SA(1, 1), a1 + hstep, voffA);
            PG8_WAIT_L(8); PG8_BAR; PG8_WAIT_L(0); PG8_MMA(0, 0, At, B0); PG8_BAR; PG8_SCHED;
            PG8_LDB(B1, 0, 1); PG8_STAGE(PG8_SB(0, 0), b2, voffB);
            PG8_BAR; PG8_WAIT_L(0); PG8_MMA(0, 1, At, B1); PG8_BAR;
            PG8_LDA(At, 0, 1); PG8_STAGE(PG8_SA(0, 0), a2, voffA);
            PG8_BAR; PG8_WAIT_L(0); PG8_MMA(1, 0, At, B0); PG8_BAR; PG8_SCHED;
            PG8_STAGE(PG8_SB(0, 1), b2 + hstep, voffB);
            PG8_WAIT_V(6); PG8_BAR; PG8_MMA(1, 1, At, B1); PG8_BAR;
            PG8_LDB(B0, 1, 0); PG8_SCHED; PG8_LDA(At, 1, 0); PG8_STAGE(PG8_SA(0, 1), a2 + hstep, voffA);
            PG8_WAIT_L(8); PG8_BAR; PG8_WAIT_L(0); PG8_MMA(0, 0, At, B0); PG8_BAR; PG8_SCHED;
            PG8_LDB(B1, 1, 1); PG8_STAGE(PG8_SB(1, 0), b3, voffB);
            PG8_BAR; PG8_WAIT_L(0); PG8_MMA(0, 1, At, B1); PG8_BAR;
            PG8_LDA(At, 1, 1); PG8_STAGE(PG8_SA(1, 0), a3, voffA);
            PG8_BAR; PG8_WAIT_L(0); PG8_MMA(1, 0, At, B0); PG8_BAR; PG8_SCHED;
            PG8_STAGE(PG8_SB(1, 1), b3 + hstep, voffB);
            PG8_WAIT_V(6); PG8_BAR; PG8_MMA(1, 1, At, B1); PG8_BAR;
            }
        }
        if constexpr (ALIGN_EPI) { if (wr == 0) PG8_BAR; }
        if constexpr (!Epi::AFTER_DRAIN) { E(acc, cur, wr, wc, fr, fq); S.done(cur); }
        if (!has_next) break;
#pragma unroll
        for (int a = 0; a < 2; ++a)
#pragma unroll
            for (int b = 0; b < 2; ++b)
#pragma unroll
                for (int m = 0; m < 4; ++m)
#pragma unroll
                    for (int n = 0; n < 2; ++n) acc[a][b][m][n] = (f32x4){0.f, 0.f, 0.f, 0.f};
        cur = nxt; cA = nA; cB = nB; ++ui;
        if constexpr (ALIGN_EPI) { if (wr == 1) PG8_BAR; }
    }
    PG8_WAIT_V(0);
    if constexpr (!ALIGN_EPI) { if (wr == 0) PG8_BAR; }
    PG8_BAR;
    if constexpr (Epi::AFTER_DRAIN) { E.fused(acc, cur, wr, wc, fr, fq, lds, wid, lane); S.done(cur); }
#undef PG8_SA
#undef PG8_SB
#undef PG8_STAGE
#undef PG8_LDA
#undef PG8_LDB
#undef PG8_MMA
#undef PG8_WAIT_V
#undef PG8_WAIT_L
#undef PG8_BAR
#undef PG8_SCHED
}
}


constexpr int NWAVES = 8;
#ifndef MK_N_LAUNCHES
#define MK_N_LAUNCHES 11
#endif
constexpr int NPHASE = 11;
constexpr int N_LAUNCHES = MK_N_LAUNCHES;

constexpr int BATCH = 4, SEQ = 4096, D = 1024, NMETA = 16;
constexpr int M = BATCH * SEQ;
constexpr int INC = 4096;
constexpr int C_QA = 0, C_KA = 512, C_VA = 1024, C_QH = 1536, C_IH = 2048, C_FF = 2560, C_FB = 3072, C_GH = 3584;
constexpr int NE = 32, TOPK = 4;
constexpr float RMS_EPS = 1e-6f;
constexpr int XROWS_MAX = 73728;
constexpr int NTILE_MAX = 288;
constexpr int LCAP = 16384;

constexpr size_t MiB = 1u << 20;
constexpr size_t WS_CTL = 0, CTL_ZERO_BYTES = 1 * MiB;
constexpr size_t WS_WIN = 1 * MiB;
constexpr size_t WS_WOUT = 9 * MiB;
constexpr size_t WS_WGU = 11 * MiB;
constexpr size_t WS_WD = 139 * MiB;
constexpr size_t WS_XN = 203 * MiB;
constexpr size_t WS_R1 = 235 * MiB;
constexpr size_t WS_VT = 379 * MiB;
constexpr size_t WS_R2 = 395 * MiB;
constexpr size_t R2_HQ = 0, R2_HK = 32 * MiB, R2_HV = 64 * MiB, R2_HA = 96 * MiB, R2_HD = 112 * MiB, R2_META = 113 * MiB, R2_OF = 116 * MiB, R2_OB = 148 * MiB;
constexpr size_t WS_Y = 575 * MiB;
constexpr size_t WS_HMID = 607 * MiB;
constexpr size_t WS_XN2 = 671 * MiB;
constexpr size_t WS_LIST = 703 * MiB;
constexpr size_t WS_SLOTW = 705 * MiB;
constexpr size_t WS_ROWTOK = 705 * MiB + 512 * 1024;
constexpr size_t WS_ROWW = 706 * MiB;
constexpr size_t WS_PROJM = 706 * MiB + 512 * 1024;
constexpr size_t WS_VTM = 706 * MiB + 768 * 1024;
constexpr size_t WS_END = 708 * MiB;
constexpr int HU_Q = 64 * 128, HU_K = 128 * 64, HU_V = 128 * 64, HU_A = 64 * 64, HU_D = 128;

constexpr int CW_TMO = 0, CW_CODE = 1;
constexpr int CW_CNT = 64;
constexpr int CW_BAR = 4096;

constexpr int RING_OFF = 0, RING_BYTES = 131072;
constexpr int LDSCTL_OFF = RING_BYTES, MISC_OFF = LDSCTL_OFF + 320;
constexpr int TILE_E_OFF = LDSCTL_OFF + 512;
constexpr int LDS_BYTES = 147456;
static_assert(TILE_E_OFF + (NTILE_MAX + 96) * 4 <= LDS_BYTES, "LDS map");
#define GAS __attribute__((address_space(1)))
#define LAS __attribute__((address_space(3)))
typedef unsigned short bf16;
typedef unsigned v4u __attribute__((ext_vector_type(4)));
typedef float f32x4 __attribute__((ext_vector_type(4)));
typedef short bf16x8 __attribute__((ext_vector_type(8)));
typedef GAS unsigned gu32;
typedef GAS unsigned long long gu64;
#define RLX_AGENT __ATOMIC_RELAXED, __HIP_MEMORY_SCOPE_AGENT
#define LDS_WAIT() asm volatile("s_waitcnt lgkmcnt(0)" ::: "memory")
#define VM_WAIT() asm volatile("s_waitcnt vmcnt(0)" ::: "memory")
__device__ __forceinline__ unsigned long long rt() { return __builtin_amdgcn_s_memrealtime(); }
__device__ __forceinline__ unsigned f2bf(float f) { unsigned u = __builtin_bit_cast(unsigned, f); return (u + 0x7fffu + ((u >> 16) & 1u)) >> 16; }
__device__ __forceinline__ unsigned pk2(float lo, float hi) { return f2bf(lo) | (f2bf(hi) << 16); }

#define XB_TMO      128
#define XB_XCNT(j)  (256  + 64 * (j))
#define XB_XSUB(j)  (1280 + 64 * (j))
#define XB_XGEN(j)  (2304 + 64 * (j))
#define XB_TOP      3328
#define XB_TOPGEN   3392
#define XCD_BAR_WORDS 3456
#define XB_SPIN_CAP (1u << 18)

__device__ __forceinline__ unsigned xb_ld(unsigned* p)              { return __hip_atomic_load(p, __ATOMIC_RELAXED, __HIP_MEMORY_SCOPE_AGENT); }
__device__ __forceinline__ unsigned xb_add(unsigned* p, unsigned v) { return __hip_atomic_fetch_add(p, v, __ATOMIC_RELAXED, __HIP_MEMORY_SCOPE_AGENT); }
__device__ __forceinline__ unsigned xb_xcc_id() { return (unsigned)__builtin_amdgcn_s_getreg((3 << 11) | 20) & 0xFu; }
#define XB_SPIN(cond, bar) do { unsigned _sp = 0; while (cond) { __builtin_amdgcn_s_sleep(1); \
    if ((++_sp & 255u) == 0u) { if (xb_ld(&(bar)[XB_TMO])) break; if (_sp > XB_SPIN_CAP) { atomicAdd(&(bar)[XB_TMO], 1u); break; } } } } while (0)

struct XcdBarrier {
    unsigned* bar; unsigned x;
    volatile LAS unsigned* st;
};

__device__ __forceinline__ XcdBarrier xcd_barrier_post(unsigned* bar, volatile LAS unsigned* st) {
    XcdBarrier b; b.bar = bar; b.x = xb_xcc_id(); b.st = st;
    if (threadIdx.x == 0) (void)xb_add(&bar[XB_XCNT(b.x)], 1u);
    return b;
}
__device__ __forceinline__ void xcd_barrier_complete(unsigned* bar, unsigned x, unsigned& nloc, unsigned& nx) {
    const unsigned G = gridDim.x * gridDim.y * gridDim.z;
    unsigned sum, cnt, mine, sp = 0u;
    for (;;) {
        sum = 0u; cnt = 0u; mine = 0u;
#pragma unroll
        for (unsigned j = 0; j < 16; ++j) { const unsigned c = xb_ld(&bar[XB_XCNT(j)]); sum += c; cnt += (c > 0u) ? 1u : 0u; mine = (j == x) ? c : mine; }
        if (sum == G) break;
        __builtin_amdgcn_s_sleep(1);
        if ((++sp & 255u) == 0u) { if (xb_ld(&bar[XB_TMO])) break; if (sp > XB_SPIN_CAP) { atomicAdd(&bar[XB_TMO], 1u); break; } }
    }
    nloc = mine > 0u ? mine : 1u; nx = cnt > 0u ? cnt : 1u;
}

__device__ __forceinline__ void xcd_barrier(const XcdBarrier& b) {
    asm volatile("s_waitcnt vmcnt(0)" ::: "memory");
    __syncthreads();
    if (threadIdx.x == 0) {
        unsigned* bar = b.bar;
        __builtin_amdgcn_s_waitcnt(0);
        unsigned nloc = b.st[0], nx = b.st[1];
        if (nloc == 0u) { xcd_barrier_complete(bar, b.x, nloc, nx); b.st[0] = nloc; b.st[1] = nx; }
        const unsigned old = xb_add(&bar[XB_XSUB(b.x)], 1u);
        const unsigned gen = old / nloc;
        if (old + 1u == (gen + 1u) * nloc) {
            __builtin_amdgcn_fence(__ATOMIC_RELEASE, "agent");
            asm volatile("s_waitcnt vmcnt(0)" ::: "memory");
            const unsigned og = xb_add(&bar[XB_TOP], 1u);
            const unsigned tg = og / nx;
            if (og + 1u == (tg + 1u) * nx) xb_add(&bar[XB_TOPGEN], 1u);
            else XB_SPIN(xb_ld(&bar[XB_TOPGEN]) == tg, bar);
            __builtin_amdgcn_fence(__ATOMIC_ACQUIRE, "agent");
            xb_add(&bar[XB_XGEN(b.x)], 1u);
            asm volatile("s_waitcnt vmcnt(0)" ::: "memory");
        } else {
            XB_SPIN(xb_ld(&bar[XB_XGEN(b.x)]) == gen, bar);
            __builtin_amdgcn_fence(__ATOMIC_ACQUIRE, "agent");
            asm volatile("s_waitcnt vmcnt(0)" ::: "memory");
        }
    }
    __syncthreads();
}


typedef unsigned v2u __attribute__((ext_vector_type(2)));
typedef float f32x2 __attribute__((ext_vector_type(2)));
struct Frame {
    LAS unsigned char* lds;
    volatile LAS unsigned* MISC;
    gu32* ctl;
    int tid, lane, wave;
    int vcu, G;
    const float* in[17];
    float* out;
    unsigned char* ws;
};
__device__ __forceinline__ float bf2f(unsigned short h) { return __builtin_bit_cast(float, (unsigned)h << 16); }
__device__ __forceinline__ float bflo(unsigned w) { return __builtin_bit_cast(float, w << 16); }
__device__ __forceinline__ float bfhi(unsigned w) { return __builtin_bit_cast(float, w & 0xffff0000u); }
__device__ __forceinline__ float sigmoidf_(float x) { return 1.0f / (1.0f + __expf(-x)); }
__device__ __forceinline__ float wave_sum(float v) {
#pragma unroll
    for (int o = 1; o < 64; o <<= 1) v += __shfl_xor(v, o);
    return v;
}
__device__ __forceinline__ f32x4 mfma16(bf16x8 a, bf16x8 b, f32x4 c) { return __builtin_amdgcn_mfma_f32_16x16x32_bf16(a, b, c, 0, 0, 0); }

template <bool GU>
__device__ __forceinline__ void p0_transpose_item(const float* W, int K, int N, bf16* WT, LAS float* scr, int item, int lane) {
    const int nblk = N / 32, kb = item / nblk, nb = item % nblk, k0 = 64 * kb, n0 = 32 * nb;
    int d0 = n0;
    if (GU) { const int c = n0 & 1023, up = n0 >> 10; d0 = (c >> 7) * 256 + up * 128 + (c & 127); }
#pragma unroll 8
    for (int i = 0; i < 32; ++i) { const int kk = 2 * i + (lane >> 5); scr[kk * 33 + (lane & 31)] = W[(size_t)(k0 + kk) * N + n0 + (lane & 31)]; }
    LDS_WAIT(); asm volatile("" ::: "memory");
    const int c = lane & 7;
#pragma unroll
    for (int j = 0; j < 4; ++j) { const int n = (lane >> 3) + 8 * j; const LAS float* s = scr + (8 * c) * 33 + n;
        v4u o; o.x = pk2(s[0 * 33], s[1 * 33]); o.y = pk2(s[2 * 33], s[3 * 33]); o.z = pk2(s[4 * 33], s[5 * 33]); o.w = pk2(s[6 * 33], s[7 * 33]);
        *(GAS v4u*)(WT + (size_t)(d0 + n) * K + k0 + 8 * c) = o; }
    LDS_WAIT(); asm volatile("" ::: "memory");
}
__device__ __forceinline__ void rms_row_to_bf16(int lane, const float* xrow, const float* g, bf16* orow) {
    const GAS f32x4* xr = (const GAS f32x4*)xrow + lane; const GAS f32x4* gr = (const GAS f32x4*)g + lane;
    f32x4 v[4]; float s = 0.f;
#pragma unroll
    for (int j = 0; j < 4; ++j) { v[j] = xr[64 * j]; s += (v[j].x * v[j].x + v[j].y * v[j].y) + (v[j].z * v[j].z + v[j].w * v[j].w); }
    const float rstd = 1.f / sqrtf(wave_sum(s) * (1.f / D) + RMS_EPS);
    GAS unsigned long long* o8 = (GAS unsigned long long*)orow + lane;
#pragma unroll
    for (int j = 0; j < 4; ++j) { const f32x4 gg = gr[64 * j];
        o8[64 * j] = (unsigned long long)pk2(v[j].x * rstd * gg.x, v[j].y * rstd * gg.y) | ((unsigned long long)pk2(v[j].z * rstd * gg.z, v[j].w * rstd * gg.w) << 32); }
}
__device__ __forceinline__ void p0_prologue(Frame& F) {
    LAS float* scr = (LAS float*)(F.lds + RING_OFF + F.wave * 16384);
    const int gw = F.vcu * NWAVES + F.wave, NGW = F.G * NWAVES;
    bf16* Win_t = (bf16*)(F.ws + WS_WIN); bf16* Wout_t = (bf16*)(F.ws + WS_WOUT); bf16* Wgu_t = (bf16*)(F.ws + WS_WGU); bf16* Wd_t = (bf16*)(F.ws + WS_WD);
    constexpr int I_IN = (D / 64) * (INC / 32), I_OUT = (D / 64) * (D / 32), I_GU = (D / 64) * (2048 / 32), I_DN = (D / 64) * (D / 32);
    constexpr int NITEMS = I_IN + I_OUT + NE * I_GU + NE * I_DN;
    for (int it = gw; it < NITEMS; it += NGW) {
        int r = it;
        if (r < I_IN) { p0_transpose_item<false>(F.in[3], D, INC, Win_t, scr, r, F.lane); continue; } r -= I_IN;
        if (r < I_OUT) { p0_transpose_item<false>(F.in[8], D, D, Wout_t, scr, r, F.lane); continue; } r -= I_OUT;
        if (r < NE * I_GU) { const int e = r / I_GU; p0_transpose_item<true>(F.in[12] + (size_t)e * D * 2048, D, 2048, Wgu_t + (size_t)e * 2048 * D, scr, r % I_GU, F.lane); continue; } r -= NE * I_GU;
        { const int e = r / I_DN; p0_transpose_item<false>(F.in[14] + (size_t)e * D * D, D, D, Wd_t + (size_t)e * D * D, scr, r % I_DN, F.lane); }
    }
    bf16* XN = (bf16*)(F.ws + WS_XN);
    for (int m = gw; m < M; m += NGW) rms_row_to_bf16(F.lane, F.in[0] + (size_t)m * D, F.in[2], XN + (size_t)m * D);
}

__device__ __forceinline__ void p1_meta_proj(Frame& F) {
    LAS float* mrow = (LAS float*)(F.lds + RING_OFF);
    const float* mt = F.in[1]; const float* g = F.in[2]; const float* Win = F.in[3];
    for (int r = F.wave; r < NMETA; r += NWAVES) {
        const GAS f32x4* xr = (const GAS f32x4*)(mt + (size_t)r * D) + F.lane; const GAS f32x4* gr = (const GAS f32x4*)g + F.lane;
        f32x4 v[4]; float s = 0.f;
#pragma unroll
        for (int j = 0; j < 4; ++j) { v[j] = xr[64 * j]; s += (v[j].x * v[j].x + v[j].y * v[j].y) + (v[j].z * v[j].z + v[j].w * v[j].w); }
        const float rstd = 1.f / sqrtf(wave_sum(s) * (1.f / D) + RMS_EPS);
#pragma unroll
        for (int j = 0; j < 4; ++j) { const f32x4 gg = gr[64 * j]; f32x4 o = v[j] * rstd * gg; *(LAS f32x4*)(mrow + r * D + 4 * F.lane + 256 * j) = o; }
    }
    __syncthreads();
    bf16* PM = (bf16*)(F.ws + WS_PROJM); bf16* VTM = (bf16*)(F.ws + WS_VTM);
    for (int cb = blockIdx.x; cb < INC / 16; cb += F.G) {
        const int r = F.tid >> 5, c = F.tid & 15, kh = (F.tid >> 4) & 1, col = cb * 16 + c;
        const LAS float* mr = mrow + r * D + kh * 512; const float* wp = Win + (size_t)(kh * 512) * INC + col;
        float a0 = 0.f, a1 = 0.f, a2 = 0.f, a3 = 0.f;
#pragma unroll 4
        for (int k = 0; k < 512; k += 4) {
            a0 += mr[k] * wp[(size_t)k * INC]; a1 += mr[k + 1] * wp[(size_t)(k + 1) * INC]; a2 += mr[k + 2] * wp[(size_t)(k + 2) * INC]; a3 += mr[k + 3] * wp[(size_t)(k + 3) * INC]; }
        float a = (a0 + a1) + (a2 + a3);
        a += __shfl_xor(a, 16);
        if (kh == 0) { const unsigned short hb = (unsigned short)f2bf(a); PM[r * INC + col] = hb;
            if (col >= C_VA && col < C_VA + 512) VTM[(col - C_VA) * 16 + r] = hb; }
    }
    __syncthreads();
}

__device__ __forceinline__ void p2_natten(Frame& F) {
    LAS float* rpbL = (LAS float*)(F.lds + RING_OFF);
    for (int i = F.tid; i < 8 * 15 * 31; i += NWAVES * 64) rpbL[i] = F.in[4][i];
    __syncthreads();
    const bf16* P = (const bf16*)(F.ws + WS_R1); const bf16* PM = (const bf16*)(F.ws + WS_PROJM);
    const bf16* VT = (const bf16*)(F.ws + WS_VT); const bf16* VTM = (const bf16*)(F.ws + WS_VTM);
    bf16* Y = (bf16*)(F.ws + WS_Y); const float* gna = F.in[5];
    const int lane = F.lane, qi = lane & 15, G = lane >> 4;
    for (int ub = F.vcu; ub < BATCH * 64; ub += F.G) {
        const int b = ub >> 6, r = ub & 63;
        int rs = r - 4; rs = rs < 0 ? 0 : (rs > 56 ? 56 : rs);
#pragma unroll 1
        for (int rd = 0; rd < 4; ++rd) {
            const int u = rd * 8 + F.wave, g = u & 3, h = u >> 2;
            const int cs0 = g == 0 ? 0 : (g == 1 ? 8 : (g == 2 ? 24 : 32));
            const int c = 16 * g + qi; int csq = c - 8; csq = csq < 0 ? 0 : (csq > 48 ? 48 : csq);
            const bf16* qp = P + (size_t)(b * SEQ + r * 64 + c) * INC + C_QA + h * 64 + 8 * G;
            const bf16x8 qf0 = *(const GAS bf16x8*)(qp), qf1 = *(const GAS bf16x8*)(qp + 32);
            f32x4 st[8][2], sm;
            const f32x4 z4 = {0.f, 0.f, 0.f, 0.f};
#pragma unroll
            for (int i = 0; i < 8; ++i)
#pragma unroll
                for (int n = 0; n < 2; ++n) {
                    const bf16* kp = P + (size_t)(b * SEQ + (rs + i) * 64 + cs0 + 16 * n + qi) * INC + C_KA + h * 64 + 8 * G;
                    const bf16x8 k0 = *(const GAS bf16x8*)(kp), k1 = *(const GAS bf16x8*)(kp + 32);
                    st[i][n] = mfma16(k0, qf0, z4); st[i][n] = mfma16(k1, qf1, st[i][n]);
                }
            { const bf16* kp = PM + (size_t)qi * INC + C_KA + h * 64 + 8 * G;
              const bf16x8 k0 = *(const GAS bf16x8*)(kp), k1 = *(const GAS bf16x8*)(kp + 32);
              sm = mfma16(k0, qf0, z4); sm = mfma16(k1, qf1, sm); }
            float mx = -1e30f;
#pragma unroll
            for (int n = 0; n < 2; ++n)
#pragma unroll
                for (int j = 0; j < 4; ++j) {
                    const int cc = cs0 + 16 * n + 4 * G + j; const bool valid = (cc >= csq) && (cc < csq + 16); const int dc = cc - c + 15;
                    const LAS float* bp = rpbL + (h * 15 + (rs - r + 7)) * 31 + (valid ? dc : 0);
#pragma unroll
                    for (int i = 0; i < 8; ++i) { const float s = valid ? st[i][n][j] * 0.125f + bp[i * 31] : -1e30f; st[i][n][j] = s; mx = fmaxf(mx, s); }
                }
#pragma unroll
            for (int j = 0; j < 4; ++j) { sm[j] *= 0.125f; mx = fmaxf(mx, sm[j]); }
            mx = fmaxf(mx, __shfl_xor(mx, 16)); mx = fmaxf(mx, __shfl_xor(mx, 32));
            float sum = 0.f;
#pragma unroll
            for (int i = 0; i < 8; ++i)
#pragma unroll
                for (int n = 0; n < 2; ++n)
#pragma unroll
                    for (int j = 0; j < 4; ++j) { const float p = __expf(st[i][n][j] - mx); st[i][n][j] = p; sum += p; }
#pragma unroll
            for (int j = 0; j < 4; ++j) { const float p = __expf(sm[j] - mx); sm[j] = p; sum += p; }
            sum += __shfl_xor(sum, 16); sum += __shfl_xor(sum, 32);
            f32x4 o[4] = {z4, z4, z4, z4};
#pragma unroll
            for (int i = 0; i < 8; ++i) {
                bf16x8 pf; { v4u w; w.x = pk2(st[i][0][0], st[i][0][1]); w.y = pk2(st[i][0][2], st[i][0][3]); w.z = pk2(st[i][1][0], st[i][1][1]); w.w = pk2(st[i][1][2], st[i][1][3]); pf = __builtin_bit_cast(bf16x8, w); }
#pragma unroll
                for (int dt = 0; dt < 4; ++dt) {
                    const bf16* vp = VT + ((size_t)(b * 512 + h * 64 + 16 * dt + qi)) * SEQ + (rs + i) * 64 + cs0 + 4 * G;
                    const v2u lo = *(const GAS v2u*)(vp), hi = *(const GAS v2u*)(vp + 16);
                    v4u w; w.x = lo.x; w.y = lo.y; w.z = hi.x; w.w = hi.y;
                    o[dt] = mfma16(pf, __builtin_bit_cast(bf16x8, w), o[dt]);
                }
            }
            { bf16x8 pf; { v4u w; w.x = pk2(sm[0], sm[1]); w.y = pk2(sm[2], sm[3]); w.z = 0u; w.w = 0u; pf = __builtin_bit_cast(bf16x8, w); }
#pragma unroll
              for (int dt = 0; dt < 4; ++dt) {
                  const bf16* vp = VTM + (size_t)(h * 64 + 16 * dt + qi) * 16 + 4 * G;
                  const v2u lo = *(const GAS v2u*)(vp);
                  v4u w; w.x = lo.x; w.y = lo.y; w.z = 0u; w.w = 0u;
                  o[dt] = mfma16(pf, __builtin_bit_cast(bf16x8, w), o[dt]);
              } }
            float ss[4];
#pragma unroll
            for (int j = 0; j < 4; ++j) { const float inv = 1.0f / __shfl(sum, 4 * G + j); float q = 0.f;
#pragma unroll
                for (int dt = 0; dt < 4; ++dt) { o[dt][j] *= inv; q += o[dt][j] * o[dt][j]; }
                q += __shfl_xor(q, 1); q += __shfl_xor(q, 2); q += __shfl_xor(q, 4); q += __shfl_xor(q, 8);
                ss[j] = 1.0f / sqrtf(q * (1.0f / 64.0f) + RMS_EPS); }
#pragma unroll
            for (int dt = 0; dt < 4; ++dt) { const float gg = gna[h * 64 + 16 * dt + qi];
#pragma unroll
                for (int j = 0; j < 4; ++j) Y[(size_t)(b * SEQ + r * 64 + 16 * g + 4 * G + j) * D + h * 64 + 16 * dt + qi] = (unsigned short)f2bf(o[dt][j] * ss[j] * gg); }
        }
    }
    __syncthreads();
}

constexpr int HP_LD = 136;
__device__ __forceinline__ void hprep_unit(Frame& F, bool meta, int b, int h, int j, int dir, bf16* HQ, bf16* HK, bf16* HV, bf16* HA, float* HDp) {
    LAS bf16* Qs = (LAS bf16*)(F.lds + RING_OFF);
    LAS bf16* Kd = Qs + 64 * HP_LD; LAS bf16* Ke = Kd + 64 * HP_LD;
    LAS bf16* Qx = Ke + 64 * HP_LD;
    LAS float* Tsh = (LAS float*)(Qx + 3 * 16 * HP_LD);
    const bf16* P = (const bf16*)(F.ws + WS_R1); const bf16* PM = (const bf16*)(F.ws + WS_PROJM);
    const int k = F.tid & 127, i = F.tid >> 7;
    const float* lbl = F.in[6] + dir * 1024 + h * 128 + k;
    const float lbv = sigmoidf_(lbl[0] - lbl[512]);
    float bl[16], kk[16], qq[16]; unsigned short vv[16];
    float run = 0.f;
    const int cf = (dir ? C_FB : C_FF) + h * 128 + k;
#pragma unroll
    for (int tt = 0; tt < 16; ++tt) {
        const int tc = 16 * i + tt;
        float xg, qv; unsigned short vraw; bool ok = true;
        if (meta) { ok = tc < NMETA; const bf16* rp = PM + (size_t)(ok ? tc : 0) * INC; xg = bf2f(rp[cf]); qv = bf2f(rp[C_QH + h * 128 + k]); vraw = rp[C_IH + h * 128 + k]; }
        else { const int tk = dir ? 63 - tc : tc; const bf16* rp = P + (size_t)(b * SEQ + 64 * j + tk) * INC; xg = bf2f(rp[cf]); qv = bf2f(rp[C_QH + h * 128 + k]); vraw = rp[C_IH + h * 128 + k]; }
        const float sg = sigmoidf_(xg);
        const float f = lbv + (1.0f - lbv) * sg;
        float gl = __logf(f); float kv = (1.0f - lbv) * (1.0f - sg); float q = qv * sigmoidf_(qv);
        if (!ok) { gl = 0.f; kv = 0.f; q = 0.f; vraw = 0; }
        run += gl; bl[tt] = run; kk[tt] = kv; qq[tt] = q; vv[tt] = vraw;
    }
    Tsh[i * 128 + k] = run;
    __syncthreads();
    const float T0 = Tsh[k], T1 = Tsh[128 + k], T2 = Tsh[256 + k], T3 = Tsh[384 + k];
    const float Ei = i == 0 ? 0.f : (i == 1 ? T0 : (i == 2 ? T0 + T1 : T0 + T1 + T2));
    const float Af = i == 0 ? T1 + T2 + T3 : (i == 1 ? T2 + T3 : (i == 2 ? T3 : 0.f));
    const float Ti = run;
    const float eE = __expf(Ei), eA = __expf(Af);
    const float x0 = __expf(i == 2 ? T1 : T2), x1 = __expf(T1 + T2);
    const int kp = (k & ~31) + 8 * ((k >> 2) & 3) + 4 * ((k >> 4) & 1) + (k & 3);
    unsigned short hk[16];
#pragma unroll
    for (int tt = 0; tt < 16; ++tt) {
        const int tc = 16 * i + tt;
        const float eb = __expf(bl[tt]); const float qs = qq[tt] * eb;
        const float kd = kk[tt] * __expf(-bl[tt]); const float ke = kk[tt] * __expf(Ti - bl[tt]);
        Qs[tc * HP_LD + k] = (unsigned short)f2bf(qs); Kd[tc * HP_LD + k] = (unsigned short)f2bf(kd); Ke[tc * HP_LD + k] = (unsigned short)f2bf(ke);
        if (i == 2) Qx[(0 * 16 + tt) * HP_LD + k] = (unsigned short)f2bf(qs * x0);
        if (i == 3) { Qx[(1 * 16 + tt) * HP_LD + k] = (unsigned short)f2bf(qs * x0); Qx[(2 * 16 + tt) * HP_LD + k] = (unsigned short)f2bf(qs * x1); }
        HQ[tc * 128 + kp] = (unsigned short)f2bf(qs * eE);
        hk[tt] = (unsigned short)f2bf(ke * eA);
    }
    { v4u w0, w1;
      w0.x = hk[0] | ((unsigned)hk[1] << 16); w0.y = hk[2] | ((unsigned)hk[3] << 16); w0.z = hk[4] | ((unsigned)hk[5] << 16); w0.w = hk[6] | ((unsigned)hk[7] << 16);
      w1.x = hk[8] | ((unsigned)hk[9] << 16); w1.y = hk[10] | ((unsigned)hk[11] << 16); w1.z = hk[12] | ((unsigned)hk[13] << 16); w1.w = hk[14] | ((unsigned)hk[15] << 16);
      *(GAS v4u*)(HK + k * 64 + 16 * i) = w0; *(GAS v4u*)(HK + k * 64 + 16 * i + 8) = w1;
      w0.x = vv[0] | ((unsigned)vv[1] << 16); w0.y = vv[2] | ((unsigned)vv[3] << 16); w0.z = vv[4] | ((unsigned)vv[5] << 16); w0.w = vv[6] | ((unsigned)vv[7] << 16);
      w1.x = vv[8] | ((unsigned)vv[9] << 16); w1.y = vv[10] | ((unsigned)vv[11] << 16); w1.z = vv[12] | ((unsigned)vv[13] << 16); w1.w = vv[14] | ((unsigned)vv[15] << 16);
      *(GAS v4u*)(HV + k * 64 + 16 * i) = w0; *(GAS v4u*)(HV + k * 64 + 16 * i + 8) = w1; }
    if (i == 0) HDp[k] = __expf(T0 + T1 + T2 + T3);
    __syncthreads();
    const int lane = F.lane, qi = lane & 15, G = lane >> 4;
    for (int job = F.wave; job < 16; job += NWAVES) {
        int ti, sj, qsel;
        switch (job) { case 0: ti = 0; sj = 0; qsel = 0; break; case 1: ti = 1; sj = 1; qsel = 0; break; case 2: ti = 2; sj = 2; qsel = 0; break; case 3: ti = 3; sj = 3; qsel = 0; break;
                       case 4: ti = 1; sj = 0; qsel = 0; break; case 5: ti = 2; sj = 1; qsel = 0; break; case 6: ti = 3; sj = 2; qsel = 0; break;
                       case 7: ti = 2; sj = 0; qsel = 1; break; case 8: ti = 3; sj = 1; qsel = 2; break; case 9: ti = 3; sj = 0; qsel = 3; break;
                       case 10: ti = 0; sj = 1; qsel = -1; break; case 11: ti = 0; sj = 2; qsel = -1; break; case 12: ti = 0; sj = 3; qsel = -1; break;
                       case 13: ti = 1; sj = 2; qsel = -1; break; case 14: ti = 1; sj = 3; qsel = -1; break; default: ti = 2; sj = 3; qsel = -1; break; }
        f32x4 acc = {0.f, 0.f, 0.f, 0.f};
        if (qsel >= 0) {
            const LAS bf16* ap = (qsel == 0 ? Qs + (16 * ti + qi) * HP_LD : Qx + ((qsel - 1) * 16 + qi) * HP_LD) + 8 * G;
            const LAS bf16* bp = (ti == sj ? Kd : Ke) + (16 * sj + qi) * HP_LD + 8 * G;
#pragma unroll
            for (int ks = 0; ks < 4; ++ks) acc = mfma16(*(const LAS bf16x8*)(ap + 32 * ks), *(const LAS bf16x8*)(bp + 32 * ks), acc);
        }
#pragma unroll
        for (int r = 0; r < 4; ++r) { float v = acc[r]; if (ti == sj && qi > 4 * G + r) v = 0.f;
            HA[(16 * ti + 4 * G + r) * 64 + 16 * sj + qi] = (unsigned short)f2bf(v); }
    }
    __syncthreads();
}
__device__ __forceinline__ void p2_hprep(Frame& F) {
    unsigned char* r2 = F.ws + WS_R2;
    for (int u = F.vcu; u < 2048 + 8; u += F.G) {
        if (u < 2048) { const int dir = u & 1, j = (u >> 1) & 63, h = (u >> 7) & 3, b = u >> 9;
            hprep_unit(F, false, b, h, j, dir, (bf16*)(r2 + R2_HQ) + (size_t)u * HU_Q, (bf16*)(r2 + R2_HK) + (size_t)u * HU_K, (bf16*)(r2 + R2_HV) + (size_t)u * HU_V,
                       (bf16*)(r2 + R2_HA) + (size_t)u * HU_A, (float*)(r2 + R2_HD) + (size_t)u * HU_D); }
        else { const int mu = u - 2048, dir = mu & 1, h = mu >> 1; unsigned char* mb = r2 + R2_META + (size_t)mu * 65536;
            hprep_unit(F, true, 0, h, 0, dir, (bf16*)(mb + 49152), (bf16*)(mb), (bf16*)(mb + 16384), (bf16*)(mb + 32768), (float*)(mb + 40960)); }
    }
}

struct HSOps { bf16x8 qf[4], af[2], kf[2][2], vf[2]; f32x4 dv[2]; };
__device__ __forceinline__ void hseq_load(HSOps& L, unsigned char* r2, int c, int b, int h, int dir, int vs, int w, int qi, int G) {
    const bf16 *HQ, *HK, *HV, *HA; const float* HDp;
    if (c == 0) { const int mu = h * 2 + dir; const unsigned char* mb = r2 + R2_META + (size_t)mu * 65536;
        HK = (const bf16*)mb; HV = (const bf16*)(mb + 16384); HA = (const bf16*)(mb + 32768); HDp = (const float*)(mb + 40960); HQ = (const bf16*)(mb + 49152); }
    else { const int j = dir ? 64 - c : c - 1; const size_t u = (size_t)(((b * 4 + h) * 64 + j) * 2 + dir);
        HQ = (const bf16*)(r2 + R2_HQ) + u * HU_Q; HK = (const bf16*)(r2 + R2_HK) + u * HU_K; HV = (const bf16*)(r2 + R2_HV) + u * HU_V;
        HA = (const bf16*)(r2 + R2_HA) + u * HU_A; HDp = (const float*)(r2 + R2_HD) + u * HU_D; }
#pragma unroll
    for (int s = 0; s < 4; ++s) L.qf[s] = *(const GAS bf16x8*)(HQ + (16 * w + qi) * 128 + 32 * s + 8 * G);
#pragma unroll
    for (int ks = 0; ks < 2; ++ks) { L.af[ks] = *(const GAS bf16x8*)(HA + (16 * w + qi) * 64 + 32 * ks + 8 * G); L.vf[ks] = *(const GAS bf16x8*)(HV + (16 * vs + qi) * 64 + 32 * ks + 8 * G);
#pragma unroll
        for (int i = 0; i < 2; ++i) L.kf[i][ks] = *(const GAS bf16x8*)(HK + (32 * w + 16 * i + qi) * 64 + 32 * ks + 8 * G); }
#pragma unroll
    for (int i = 0; i < 2; ++i) L.dv[i] = *(const GAS f32x4*)(HDp + 32 * w + 16 * i + 4 * G);
}
__device__ __forceinline__ void p3_hseq(Frame& F) {
    const int blk = blockIdx.x;
    const int x = blk & 7, q = blk >> 3, chain = (x * 4 + (q >> 3)) & 31, vs = q & 7;
    const int dir = chain & 1, h = (chain >> 1) & 3, b = chain >> 3;
    unsigned char* r2 = F.ws + WS_R2;
    float* Od = (float*)(r2 + (dir ? R2_OB : R2_OF));
    LAS v4u* sbuf = (LAS v4u*)(F.lds + RING_OFF);
    const int lane = F.lane, qi = lane & 15, G = lane >> 4, w = F.wave;
    const bool act = (w < 4) && (blk < 256);
    f32x4 s0 = {0.f, 0.f, 0.f, 0.f}, s1 = {0.f, 0.f, 0.f, 0.f};
    HSOps cur, nxt;
    if (act) hseq_load(cur, r2, 0, b, h, dir, vs, w, qi, G);
#pragma unroll 1
    for (int c = 0; c <= 64; ++c) {
        if (act) {
            if (c < 64) hseq_load(nxt, r2, c + 1, b, h, dir, vs, w, qi, G);
            v4u sw; sw.x = pk2(s0[0], s0[1]); sw.y = pk2(s0[2], s0[3]); sw.z = pk2(s1[0], s1[1]); sw.w = pk2(s1[2], s1[3]);
            sbuf[((c & 1) * 4 + w) * 64 + lane] = sw;
        }
        __syncthreads();
        if (act) {
            f32x4 o = {0.f, 0.f, 0.f, 0.f};
            if (c > 0) {
#pragma unroll
                for (int s = 0; s < 4; ++s) { const v4u sb = sbuf[((c & 1) * 4 + s) * 64 + lane]; o = mfma16(cur.qf[s], __builtin_bit_cast(bf16x8, sb), o); }
#pragma unroll
                for (int ks = 0; ks < 2; ++ks) o = mfma16(cur.af[ks], cur.vf[ks], o);
            }
            s0 = s0 * cur.dv[0]; s1 = s1 * cur.dv[1];
#pragma unroll
            for (int ks = 0; ks < 2; ++ks) { s0 = mfma16(cur.kf[0][ks], cur.vf[ks], s0); s1 = mfma16(cur.kf[1][ks], cur.vf[ks], s1); }
            if (c > 0) { const int j = dir ? 64 - c : c - 1;
#pragma unroll
                for (int r = 0; r < 4; ++r) { const int tc = 16 * w + 4 * G + r, tk = dir ? 63 - tc : tc;
                    Od[(size_t)(b * SEQ + 64 * j + tk) * 512 + h * 128 + 16 * vs + qi] = o[r]; }
            }
            cur = nxt;
        }
    }
    __syncthreads();
}

__device__ __forceinline__ void p4_combine(Frame& F) {
    const int gw = F.vcu * NWAVES + F.wave, NGW = F.G * NWAVES, lane = F.lane;
    const float* OF = (const float*)(F.ws + WS_R2 + R2_OF); const float* OB = (const float*)(F.ws + WS_R2 + R2_OB);
    const bf16* P = (const bf16*)(F.ws + WS_R1); bf16* Y = (bf16*)(F.ws + WS_Y); const float* gn = F.in[7];
    for (int m = gw; m < M; m += NGW) {
        const int c0 = 8 * lane;
        const f32x4 a0 = *(const GAS f32x4*)(OF + (size_t)m * 512 + c0), a1 = *(const GAS f32x4*)(OF + (size_t)m * 512 + c0 + 4);
        const f32x4 b0 = *(const GAS f32x4*)(OB + (size_t)m * 512 + c0), b1 = *(const GAS f32x4*)(OB + (size_t)m * 512 + c0 + 4);
        const v4u gt = *(const GAS v4u*)(P + (size_t)m * INC + C_GH + c0);
        const f32x4 g0 = *(const GAS f32x4*)(gn + c0), g1 = *(const GAS f32x4*)(gn + c0 + 4);
        const f32x4 o0 = a0 + b0, o1 = a1 + b1;
        float q = (o0.x * o0.x + o0.y * o0.y) + (o0.z * o0.z + o0.w * o0.w) + (o1.x * o1.x + o1.y * o1.y) + (o1.z * o1.z + o1.w * o1.w);
        q += __shfl_xor(q, 1); q += __shfl_xor(q, 2); q += __shfl_xor(q, 4); q += __shfl_xor(q, 8);
        const float rstd = 1.0f / sqrtf(q * (1.0f / 128.0f) + RMS_EPS);
        float gv[8] = {bflo(gt.x), bfhi(gt.x), bflo(gt.y), bfhi(gt.y), bflo(gt.z), bfhi(gt.z), bflo(gt.w), bfhi(gt.w)};
        float ov[8] = {o0.x * g0.x, o0.y * g0.y, o0.z * g0.z, o0.w * g0.w, o1.x * g1.x, o1.y * g1.y, o1.z * g1.z, o1.w * g1.w};
#pragma unroll
        for (int i = 0; i < 8; ++i) ov[i] = ov[i] * rstd * (gv[i] * sigmoidf_(gv[i]));
        v4u wv; wv.x = pk2(ov[0], ov[1]); wv.y = pk2(ov[2], ov[3]); wv.z = pk2(ov[4], ov[5]); wv.w = pk2(ov[6], ov[7]);
        *(GAS v4u*)(Y + (size_t)m * D + 512 + c0) = wv;
    }
}

__device__ __forceinline__ void p6_router(Frame& F) {
    LAS float* Wr = (LAS float*)(F.lds + RING_OFF);
    LAS int* cntL = (LAS int*)(F.lds + TILE_E_OFF);
    LAS int* baseL = cntL + 32; LAS int* selE = cntL + 64; LAS int* selP = selE + 256; LAS float* selW = (LAS float*)(selP + 256);
    static_assert(TILE_E_OFF + (64 + 768) * 4 <= LDS_BYTES, "router LDS");
    { const GAS f32x4* src = (const GAS f32x4*)F.in[10]; for (int i = F.tid; i < 1024 * 32 / 4; i += NWAVES * 64) *(LAS f32x4*)(Wr + 4 * i) = src[i]; }
    if (F.tid < 32) cntL[F.tid] = 0;
    __syncthreads();
    const float* HM = (const float*)(F.ws + WS_HMID); bf16* XN2 = (bf16*)(F.ws + WS_XN2);
    const float* g2 = F.in[9]; const float* rb = F.in[11];
    const int lane = F.lane, e4 = lane & 7, kq = lane >> 3, kl = kq + 8 * e4;
    for (int rb0 = F.vcu * 64; rb0 < M; rb0 += F.G * 64) {
#pragma unroll 1
        for (int rr = 0; rr < 8; ++rr) {
            const int rl = F.wave * 8 + rr, row = rb0 + rl;
            float xv[16]; float s = 0.f;
#pragma unroll
            for (int m = 0; m < 16; ++m) { xv[m] = HM[(size_t)row * D + kl + 64 * m]; s += xv[m] * xv[m]; }
            const float rstd = 1.f / sqrtf(wave_sum(s) * (1.f / D) + RMS_EPS);
#pragma unroll
            for (int m = 0; m < 16; ++m) { xv[m] = xv[m] * rstd * g2[kl + 64 * m]; XN2[(size_t)row * D + kl + 64 * m] = (unsigned short)f2bf(xv[m]); }
            float a0 = 0.f, a1 = 0.f, a2 = 0.f, a3 = 0.f;
#pragma unroll
            for (int m = 0; m < 16; ++m)
#pragma unroll
                for (int ep = 0; ep < 8; ++ep) {
                    const float xb = __shfl(xv[m], (lane & ~7) + ep);
                    const f32x4 wv = *(const LAS f32x4*)(Wr + (kq + 8 * ep + 64 * m) * 32 + 4 * e4);
                    a0 += xb * wv.x; a1 += xb * wv.y; a2 += xb * wv.z; a3 += xb * wv.w;
                }
#pragma unroll
            for (int o = 8; o < 64; o <<= 1) { a0 += __shfl_xor(a0, o); a1 += __shfl_xor(a1, o); a2 += __shfl_xor(a2, o); a3 += __shfl_xor(a3, o); }
            float lg[32];
#pragma unroll
            for (int ep = 0; ep < 8; ++ep) { lg[4 * ep] = __shfl(a0, ep) + rb[4 * ep]; lg[4 * ep + 1] = __shfl(a1, ep) + rb[4 * ep + 1]; lg[4 * ep + 2] = __shfl(a2, ep) + rb[4 * ep + 2]; lg[4 * ep + 3] = __shfl(a3, ep) + rb[4 * ep + 3]; }
            int ti[4]; float tv[4];
#pragma unroll
            for (int t = 0; t < 4; ++t) { float best = -3.0e38f; int bi = 0;
#pragma unroll
                for (int e = 0; e < 32; ++e) { const bool tk = (t > 0 && ti[0] == e) || (t > 1 && ti[1] == e) || (t > 2 && ti[2] == e); if (!tk && lg[e] > best) { best = lg[e]; bi = e; } }
                ti[t] = bi; tv[t] = best; }
            const float p1 = __expf(tv[1] - tv[0]), p2 = __expf(tv[2] - tv[0]), p3 = __expf(tv[3] - tv[0]); const float inv = 1.0f / (1.0f + p1 + p2 + p3);
            const float wsm[4] = {inv, p1 * inv, p2 * inv, p3 * inv};
            if (lane < 4) { const int e = lane == 0 ? ti[0] : (lane == 1 ? ti[1] : (lane == 2 ? ti[2] : ti[3])); const float wv = lane == 0 ? wsm[0] : (lane == 1 ? wsm[1] : (lane == 2 ? wsm[2] : wsm[3]));
                const int lp = __hip_atomic_fetch_add(cntL + e, 1, __ATOMIC_RELAXED, __HIP_MEMORY_SCOPE_WORKGROUP);
                selE[rl * 4 + lane] = e; selP[rl * 4 + lane] = lp; selW[rl * 4 + lane] = wv; }
        }
        __syncthreads();
        if (F.tid < 32) { const int n = cntL[F.tid]; baseL[F.tid] = n > 0 ? (int)__hip_atomic_fetch_add(F.ctl + CW_CNT + F.tid, (unsigned)n, RLX_AGENT) : 0; }
        __syncthreads();
        if (F.tid < 256) { const int e = selE[F.tid], pos = baseL[e] + selP[F.tid]; const int tok4 = (rb0 + (F.tid >> 2)) * 4 + (F.tid & 3);
            ((int*)(F.ws + WS_LIST))[(size_t)e * LCAP + pos] = tok4; ((float*)(F.ws + WS_SLOTW))[tok4] = selW[F.tid]; }
        __syncthreads();
        if (F.tid < 32) cntL[F.tid] = 0;
        __syncthreads();
    }
}

__device__ __forceinline__ int moe_table(Frame& F) {
    LAS int* tileE = (LAS int*)(F.lds + TILE_E_OFF); LAS int* rowbase = tileE + NTILE_MAX; LAS int* cntS = rowbase + 32; LAS int* ntS = cntS + 32;
    if (F.tid == 0) { int nt = 0;
        for (int e = 0; e < NE; ++e) { const int c = (int)__hip_atomic_load(F.ctl + CW_CNT + e, RLX_AGENT); cntS[e] = c; rowbase[e] = nt * 256; const int t = (c + 255) >> 8; for (int i = 0; i < t; ++i) tileE[nt + i] = e; nt += t; }
        ntS[0] = nt; }
    __syncthreads();
    return ntS[0];
}
__device__ __forceinline__ void p7_gather(Frame& F, int NT) {
    LAS int* tileE = (LAS int*)(F.lds + TILE_E_OFF); LAS int* rowbase = tileE + NTILE_MAX; LAS int* cntS = rowbase + 32;
    const int gw = F.vcu * NWAVES + F.wave, NGW = F.G * NWAVES, lane = F.lane;
    const bf16* XN2 = (const bf16*)(F.ws + WS_XN2); bf16* XB = (bf16*)(F.ws + WS_R1);
    const int* list = (const int*)(F.ws + WS_LIST); const float* slotw = (const float*)(F.ws + WS_SLOTW);
    int* rowtok = (int*)(F.ws + WS_ROWTOK); float* roww = (float*)(F.ws + WS_ROWW);
    for (int xr = gw; xr < NT * 256; xr += NGW) {
        const int e = tileE[xr >> 8], p = xr - rowbase[e];
        v4u a = {0u, 0u, 0u, 0u}, b = {0u, 0u, 0u, 0u}; int tk = -1; float w = 0.f;
        if (p < cntS[e]) { tk = list[(size_t)e * LCAP + p]; w = slotw[tk]; const GAS v4u* src = (const GAS v4u*)(XN2 + (size_t)(tk >> 2) * D); a = src[lane]; b = src[64 + lane]; }
        GAS v4u* dst = (GAS v4u*)(XB + (size_t)xr * D); dst[lane] = a; dst[64 + lane] = b;
        if (lane == 0) { rowtok[xr] = tk; roww[xr] = w; }
    }
}

__device__ __forceinline__ void p9_final(Frame& F) {
    const int gw = F.vcu * NWAVES + F.wave, NGW = F.G * NWAVES, lane = F.lane;
    const float* HM = (const float*)(F.ws + WS_HMID); const bf16* YS = (const bf16*)(F.ws + WS_R1); const float* gf = F.in[16];
    for (int m = gw; m < M; m += NGW) {
        f32x4 v[4]; float s = 0.f;
#pragma unroll
        for (int j = 0; j < 4; ++j) { v[j] = *(const GAS f32x4*)(HM + (size_t)m * D + 4 * lane + 256 * j);
#pragma unroll
            for (int k = 0; k < 4; ++k) { const v2u y = *(const GAS v2u*)(YS + ((size_t)m * 4 + k) * D + 4 * lane + 256 * j); v[j].x += bflo(y.x); v[j].y += bfhi(y.x); v[j].z += bflo(y.y); v[j].w += bfhi(y.y); }
            s += (v[j].x * v[j].x + v[j].y * v[j].y) + (v[j].z * v[j].z + v[j].w * v[j].w); }
        const float rstd = 1.f / sqrtf(wave_sum(s) * (1.f / D) + RMS_EPS);
#pragma unroll
        for (int j = 0; j < 4; ++j) { const f32x4 gg = *(const GAS f32x4*)(gf + 4 * lane + 256 * j); *(GAS f32x4*)(F.out + (size_t)m * D + 4 * lane + 256 * j) = v[j] * rstd * gg; }
    }
}

struct Args { const float* in[17]; float* out; unsigned char* ws; int ph_lo, ph_hi, li, pad; };
__global__ void __launch_bounds__(NWAVES * 64, 2) hymba_fwd(Args args) {
    extern __shared__ __attribute__((aligned(16))) unsigned char lds[];
    Frame F;
    F.lds = (LAS unsigned char*)lds;
    F.MISC = (volatile LAS unsigned*)(F.lds + MISC_OFF);
    F.tid = threadIdx.x; F.lane = F.tid & 63; F.wave = __builtin_amdgcn_readfirstlane(F.tid >> 6);
    F.G = gridDim.x; { const int bx = blockIdx.x; F.vcu = (F.G % 8 == 0) ? (bx % 8) * (F.G / 8) + bx / 8 : bx; }
    F.ws = args.ws; F.ctl = (gu32*)(args.ws + WS_CTL); F.out = args.out;
#pragma unroll
    for (int i = 0; i < 17; ++i) F.in[i] = args.in[i];
    for (int u = F.tid; u < (LDS_BYTES - LDSCTL_OFF) / 4; u += NWAVES * 64) ((LAS unsigned*)(F.lds + LDSCTL_OFF))[u] = 0u;
    __syncthreads();
    XcdBarrier bar; bar.bar = (unsigned*)(F.ctl + CW_BAR); bar.x = 0; bar.st = nullptr;
    if (N_LAUNCHES == 1) bar = xcd_barrier_post((unsigned*)(F.ctl + CW_BAR), F.MISC + 8);
#define GRID_BAR() do { if (N_LAUNCHES == 1) xcd_barrier(bar); } while (0)
    const int lo = args.ph_lo, hi = args.ph_hi;
#define IN(k) (lo <= (k) && (k) < hi)
#define BOTH(k) (IN(k) && IN((k) + 1))

    if (IN(0)) { p0_prologue(F); if (BOTH(0)) GRID_BAR(); }
    if (IN(1)) {
        p1_meta_proj(F);
        pg8::Gemm g{(const bf16*)(F.ws + WS_XN), (const bf16*)(F.ws + WS_WIN), M, INC, D}; pg8::StaticOrder S; S.init(M, INC, F.G, (int)blockIdx.x);
        pg8::EpiProj E{(bf16*)(F.ws + WS_R1), (bf16*)(F.ws + WS_VT)};
        pg8::gemm_phase<pg8::EpiProj, pg8::StaticOrder, true, true>(F.lds + RING_OFF, g, S, E);
        if (BOTH(1)) GRID_BAR();
    }
    if (IN(2)) { p2_natten(F); p2_hprep(F); if (BOTH(2)) GRID_BAR(); }
    if (IN(3)) { p3_hseq(F); if (BOTH(3)) GRID_BAR(); }
    if (IN(4)) { p4_combine(F); if (BOTH(4)) GRID_BAR(); }
    if (IN(5)) {
        pg8::Gemm g{(const bf16*)(F.ws + WS_Y), (const bf16*)(F.ws + WS_WOUT), M, D, D}; pg8::StaticOrder S; S.init(M, D, F.G, (int)blockIdx.x);
        pg8::EpiResF32 E{F.in[0], (float*)(F.ws + WS_HMID)};
        pg8::gemm_phase<pg8::EpiResF32, pg8::StaticOrder, false, true>(F.lds + RING_OFF, g, S, E);
        if (BOTH(5)) GRID_BAR();
    }
    if (IN(6)) { p6_router(F); if (BOTH(6)) GRID_BAR(); }
    if (IN(7)) { const int NT = moe_table(F); p7_gather(F, NT); if (BOTH(7)) GRID_BAR(); }
    if (IN(8)) {
        const int NT = moe_table(F);
        pg8::Gemm g{(const bf16*)(F.ws + WS_R1), (const bf16*)(F.ws + WS_WGU), NT * 256, 2048, D}; pg8::MoeOrder S; S.init(NT, 8, F.G, (int)blockIdx.x, 2048, (const LAS int*)(F.lds + TILE_E_OFF));
        pg8::EpiSwiglu E{(bf16*)(F.ws + WS_R2), F.in[13]};
        pg8::gemm_phase<pg8::EpiSwiglu, pg8::MoeOrder, true, true>(F.lds + RING_OFF, g, S, E);
        if (BOTH(8)) GRID_BAR();
    }
    if (IN(9)) {
        const int NT = moe_table(F);
        pg8::Gemm g{(const bf16*)(F.ws + WS_R2), (const bf16*)(F.ws + WS_WD), NT * 256, 1024, D}; pg8::MoeOrder S; S.init(NT, 4, F.G, (int)blockIdx.x, 1024, (const LAS int*)(F.lds + TILE_E_OFF));
        pg8::EpiDown E{(bf16*)(F.ws + WS_R1), F.in[15], (const int*)(F.ws + WS_ROWTOK), (const float*)(F.ws + WS_ROWW)};
        pg8::gemm_phase<pg8::EpiDown, pg8::MoeOrder, true, true>(F.lds + RING_OFF, g, S, E);
        if (BOTH(9)) GRID_BAR();
    }
    if (IN(10)) { p9_final(F); }
#undef IN
#undef BOTH
}

extern "C" void kernel_launch(void* const* d_in, const int* in_sizes, int n_in, void* d_out, int out_size, void* d_ws, size_t ws_size, hipStream_t stream) {
    static int grid = 0;
    if (grid == 0) {
        if (n_in != 17 || in_sizes[0] != M * D || out_size != M * D || ws_size < WS_END) { fprintf(stderr, "kernel_launch: unexpected shapes (n_in %d, in0 %d, out %d, ws %zu); nothing launched\n", n_in, n_in > 0 ? in_sizes[0] : -1, out_size, ws_size); grid = -1; return; }
        int dev = 0, cus = 0, per_cu = 0;
        if (hipGetDevice(&dev) != hipSuccess || hipDeviceGetAttribute(&cus, hipDeviceAttributeMultiprocessorCount, dev) != hipSuccess) { grid = -1; return; }
        if (hipFuncSetAttribute((const void*)hymba_fwd, hipFuncAttributeMaxDynamicSharedMemorySize, LDS_BYTES) != hipSuccess) { fprintf(stderr, "kernel_launch: hipFuncSetAttribute failed\n"); grid = -1; return; }
        if (hipOccupancyMaxActiveBlocksPerMultiprocessor(&per_cu, (const void*)hymba_fwd, NWAVES * 64, LDS_BYTES) != hipSuccess || per_cu < 1)
            fprintf(stderr, "kernel_launch: note: occupancy query reports %d workgroups per CU\n", per_cu);
        (void)hipGetLastError();
        grid = cus;
        if (grid != 256) fprintf(stderr, "kernel_launch: note: %d CUs\n", grid);
    }
    if (grid < 0) return;
    if (hipMemsetAsync((char*)d_ws + WS_CTL, 0, CTL_ZERO_BYTES, stream) != hipSuccess) { fprintf(stderr, "kernel_launch: memset failed\n"); return; }
    Args a{};
    for (int i = 0; i < 17; ++i) a.in[i] = (const float*)d_in[i];
    a.out = (float*)d_out; a.ws = (unsigned char*)d_ws;
    if (N_LAUNCHES == 1) { a.ph_lo = 0; a.ph_hi = NPHASE; a.li = 0; hipLaunchKernelGGL(hymba_fwd, dim3(grid), dim3(NWAVES * 64), LDS_BYTES, stream, a); }
    else for (int li = 0; li < NPHASE; ++li) { a.ph_lo = li; a.ph_hi = li + 1; a.li = li; hipLaunchKernelGGL(hymba_fwd, dim3(grid), dim3(NWAVES * 64), LDS_BYTES, stream, a); }
    const hipError_t le = hipPeekAtLastError();
    if (le != hipSuccess) fprintf(stderr, "kernel_launch: launch failed: %s\n", hipGetErrorName(le));
}
```

```cpp
#include <hip/hip_runtime.h>
#include <cstdio>
#include <cstdint>

namespace pg8 {
#define PG8_LAS __attribute__((address_space(3)))
typedef unsigned short bf16_t;
typedef short bf16x8 __attribute__((ext_vector_type(8)));
typedef float f32x4 __attribute__((ext_vector_type(4)));
typedef unsigned u32x4 __attribute__((ext_vector_type(4)));
constexpr int BM = 256, BK = 64, HALF = 128, HTB = HALF * BK * 2  , STAGE_BYTES = 8 * HTB, NXCD = 8, WGM = 8;

__host__ __device__ __forceinline__ int lds_byte(int r, int c) { const int st = (r >> 4) * 2 + (c >> 5), rr = r & 15, cc = c & 31, ob = rr * 64 + cc * 2; return st * 1024 + (ob ^ (((ob >> 9) & 1) << 5)); }
__host__ __device__ __forceinline__ void stage_rc(int b, int& R, int& C) { const int st = b / 1024, sb = b % 1024, swz = sb ^ (((sb >> 9) & 1) << 5); R = (st >> 1) * 16 + swz / 64; C = (st & 1) * 32 + (swz % 64) / 2; }
__host__ __device__ __forceinline__ int perm32(int rho) { const int n = rho >> 4, i = rho & 15; return 8 * (i >> 2) + 4 * n + (i & 3); }

struct Unit { int pm, pn, pb, e, hm; };
struct Gemm { const bf16_t* A; const bf16_t* Bt; int M, N, K; };

struct StaticOrder {
    static constexpr bool SPLIT = false;
    int nM, nN, nwg, G, c;
    __host__ __device__ void init(int M, int N, int G_, int c_) { nM = M / BM; nN = N / BM; nwg = nM * nN; G = G_; c = c_; }
    __host__ __device__ bool next(int i, Unit& u) const {
        const long L = (long)i * G + c; if (L >= nwg) return false;
        int wgid = (int)L; { const int q = nwg / NXCD, r = nwg % NXCD, xcd = wgid % NXCD, off = wgid / NXCD; wgid = (xcd < r ? xcd * (q + 1) : r * (q + 1) + (xcd - r) * q) + off; }
        const int nig = WGM * nN, gid = wgid / nig, fm = gid * WGM, gsz = (nM - fm) < WGM ? (nM - fm) : WGM;
        u.pm = fm + ((wgid % nig) % gsz); u.pn = (wgid % nig) / gsz; u.pb = u.pn * BM; u.e = 0; u.hm = 3; return true;
    }
    __device__ __forceinline__ unsigned row_off(const Unit&, int) const { return 0u; }
    __device__ __forceinline__ void row_off4(const Unit&, const int (&)[4], unsigned (&o)[4]) const { o[0] = o[1] = o[2] = o[3] = 0u; }
    __device__ __forceinline__ void a_ready(const Unit&) const {}
    __device__ __forceinline__ void done(const Unit&) const {}
};
template <bool SPLIT_>
struct MoeOrderT {
    static constexpr bool SPLIT = SPLIT_;
    int nM, nN, nwg, G, c, NB; const PG8_LAS int* tile_e; const PG8_LAS int* rowbase; const PG8_LAS int* cnt; const int* list; int lcap;
    __device__ void init(int nM_, int nN_, int G_, int c_, int NB_, const PG8_LAS int* te, const int* list_, int lcap_) { nM = nM_; nN = nN_; nwg = nM * nN; G = G_; c = c_; NB = NB_; tile_e = te; rowbase = te + 288; cnt = te + 320; list = list_; lcap = lcap_; }
    __device__ bool next(int i, Unit& u) const {
        long L = (long)i * G + c; int hm = 3;
        if (SPLIT) { const int nfull = (nwg / G) * G, rem = nwg - nfull;
            if (rem > 0 && 2 * rem <= G && L >= nfull) { const long h = L - nfull; if (h >= 2 * rem) return false; L = nfull + (h >> 1); hm = 1 << (int)(h & 1); } }
        if (L >= nwg) return false;
        int wgid = (int)L; { const int q = nwg / NXCD, r = nwg % NXCD, xcd = wgid % NXCD, off = wgid / NXCD; wgid = (xcd < r ? xcd * (q + 1) : r * (q + 1) + (xcd - r) * q) + off; }
        const int nig = WGM * nN, gid = wgid / nig, fm = gid * WGM, gsz = (nM - fm) < WGM ? (nM - fm) : WGM;
        u.pm = fm + ((wgid % nig) % gsz); u.pn = (wgid % nig) / gsz; u.e = tile_e[u.pm]; u.pb = u.e * NB + u.pn * BM; u.hm = hm; return true;
    }
    __device__ __forceinline__ unsigned row_entry(const Unit& u, int r) const { const int p = u.pm * BM + r - rowbase[u.e]; const bool ok = p < cnt[u.e];
        const unsigned v = (unsigned)list[(size_t)u.e * lcap + (ok ? p : 0)]; return ok ? v : 0xffffffffu; }
    __device__ __forceinline__ unsigned row_off(const Unit& u, int r) const { const unsigned s = row_entry(u, r); return s == 0xffffffffu ? 0u : ((s & 0xffffu) >> 2); }
    __device__ __forceinline__ void row_off4(const Unit& u, const int (&r)[4], unsigned (&o)[4]) const {
        const int rb = rowbase[u.e], cn = cnt[u.e]; unsigned v[4]; bool ok[4];
#pragma unroll
        for (int q = 0; q < 4; ++q) { const int p = u.pm * BM + r[q] - rb; ok[q] = p < cn; v[q] = (unsigned)list[(size_t)u.e * lcap + (ok[q] ? p : 0)]; }
#pragma unroll
        for (int q = 0; q < 4; ++q) o[q] = ok[q] ? ((v[q] & 0xffffu) >> 2) : 0u;
    }
    __device__ __forceinline__ void a_ready(const Unit&) const {}
    __device__ __forceinline__ void done(const Unit&) const {}
};
typedef MoeOrderT<false> MoeOrder; typedef MoeOrderT<true> MoeOrderSplit;

__device__ __forceinline__ unsigned cvt_pk_bf16(float lo, float hi) { unsigned r; asm volatile("v_cvt_pk_bf16_f32 %0, %1, %2" : "=v"(r) : "v"(lo), "v"(hi)); return r; }

struct NoPre {};
struct EpiProj {
    static constexpr bool PERM = true, AFTER_DRAIN = false;
    typedef NoPre Pre; __device__ __forceinline__ void pre(Pre&, const Unit&, int, int, int, int) const {}
    bf16_t* P;
    __device__ __forceinline__ void operator()(const f32x4 (&acc)[2][2][4][2], const Unit& u, int wr, int wc, int fr, int fq, const Pre&) const {
        const int row0 = u.pm * BM + wr * 64 + fr;
        {
            const int col0 = u.pn * BM + wc * 32 + 8 * fq;
#pragma unroll
            for (int ai = 0; ai < 2; ++ai)
#pragma unroll
                for (int m = 0; m < 4; ++m) { bf16_t* rowp = P + (size_t)(row0 + ai * HALF + m * 16) * 4096 + col0;
#pragma unroll
                    for (int bj = 0; bj < 2; ++bj) { const f32x4 v0 = acc[ai][bj][m][0], v1 = acc[ai][bj][m][1];
                        u32x4 w; w.x = cvt_pk_bf16(v0[0], v0[1]); w.y = cvt_pk_bf16(v0[2], v0[3]); w.z = cvt_pk_bf16(v1[0], v1[1]); w.w = cvt_pk_bf16(v1[2], v1[3]);
                        *(u32x4*)(rowp + bj * HALF) = w; } }
        }
    }
};
struct EpiResF32 {
    static constexpr bool PERM = false, AFTER_DRAIN = false;
    typedef NoPre Pre; __device__ __forceinline__ void pre(Pre&, const Unit&, int, int, int, int) const {}
    const float* base; float* out; float* rowss;
    __device__ __forceinline__ void operator()(const f32x4 (&acc)[2][2][4][2], const Unit& u, int wr, int wc, int fr, int fq, const Pre&) const {
        const int row0 = u.pm * BM + wr * 64 + fr, col0 = u.pn * BM + wc * 32 + 4 * fq;
#pragma unroll
        for (int ai = 0; ai < 2; ++ai) {
            f32x4 bs[4][2][2];
#pragma unroll
            for (int m = 0; m < 4; ++m) { const size_t off = (size_t)(row0 + ai * HALF + m * 16) * 1024 + col0;
#pragma unroll
                for (int bj = 0; bj < 2; ++bj)
#pragma unroll
                    for (int n = 0; n < 2; ++n) bs[m][bj][n] = *(const f32x4*)(base + off + bj * HALF + n * 16); }
            __builtin_amdgcn_sched_barrier(0);
#pragma unroll
            for (int m = 0; m < 4; ++m) { const size_t off = (size_t)(row0 + ai * HALF + m * 16) * 1024 + col0; float ss = 0.f;
#pragma unroll
                for (int bj = 0; bj < 2; ++bj)
#pragma unroll
                    for (int n = 0; n < 2; ++n) { const f32x4 o = bs[m][bj][n] + acc[ai][bj][m][n]; *(f32x4*)(out + off + bj * HALF + n * 16) = o;
                        ss += (o[0] * o[0] + o[1] * o[1]) + (o[2] * o[2] + o[3] * o[3]); }
                ss += __shfl_xor(ss, 16); ss += __shfl_xor(ss, 32);
                if (fq == 0) rowss[(size_t)(row0 + ai * HALF + m * 16) * 16 + u.pn * 4 + wc] = ss; }
        }
    }
};
__device__ __forceinline__ unsigned pk4_fp8(float a, float b, float c, float d) { int p = __builtin_amdgcn_cvt_pk_fp8_f32(a, b, 0, false); p = __builtin_amdgcn_cvt_pk_fp8_f32(c, d, p, true); return (unsigned)p; }
struct EpiDown {
    static constexpr bool PERM = true, AFTER_DRAIN = false;
    unsigned char* ys; const float* bd; const MoeOrderSplit* ord;
    struct Pre { unsigned ent[2][4]; };
    __device__ __forceinline__ void pre(Pre& p, const Unit& u, int wr, int, int fr, int) const {
#pragma unroll
        for (int ai = 0; ai < 2; ++ai)
#pragma unroll
            for (int m = 0; m < 4; ++m) p.ent[ai][m] = ord->row_entry(u, wr * 64 + fr + ai * HALF + m * 16);
    }
    __device__ __forceinline__ void operator()(const f32x4 (&acc)[2][2][4][2], const Unit& u, int wr, int wc, int fr, int fq, const Pre& p) const {
        typedef unsigned u32x2 __attribute__((ext_vector_type(2)));
        const int c0 = u.pn * BM + wc * 32 + 8 * fq;
        const float* b = bd + (size_t)u.e * 1024 + c0;
        f32x4 bv[2][2];
#pragma unroll
        for (int bj = 0; bj < 2; ++bj)
#pragma unroll
            for (int n = 0; n < 2; ++n) bv[bj][n] = *(const f32x4*)(b + bj * HALF + 4 * n);
        asm volatile("" : "+v"(bv[0][0]), "+v"(bv[0][1]), "+v"(bv[1][0]), "+v"(bv[1][1]));
#pragma unroll
        for (int ai = 0; ai < 2; ++ai)
#pragma unroll
            for (int m = 0; m < 4; ++m) { const unsigned en = p.ent[ai][m];
                if (en != 0xffffffffu && ((u.hm >> ai) & 1)) { const unsigned tk = en & 0xffffu; const float w = __builtin_bit_cast(float, en & 0xffff0000u) * 8.0f;
#pragma unroll
                    for (int bj = 0; bj < 2; ++bj) { f32x4 v0 = (acc[ai][bj][m][0] + bv[bj][0]) * w, v1 = (acc[ai][bj][m][1] + bv[bj][1]) * w;
#pragma unroll
                        for (int q = 0; q < 4; ++q) { v0[q] = fminf(fmaxf(v0[q], -448.0f), 448.0f); v1[q] = fminf(fmaxf(v1[q], -448.0f), 448.0f); }
                        u32x2 o; o.x = pk4_fp8(v0[0], v0[1], v0[2], v0[3]); o.y = pk4_fp8(v1[0], v1[1], v1[2], v1[3]);
                        *(u32x2*)(ys + (size_t)tk * 1024 + c0 + bj * HALF) = o; } } }
    }
};

typedef int i32x8 __attribute__((ext_vector_type(8)));
constexpr float W8_SCALE = 64.0f;
__device__ __forceinline__ f32x4 mma_f8(bf16x8 b0, bf16x8 b1, bf16x8 a0, bf16x8 a1, f32x4 c) {
    typedef int i32x4 __attribute__((ext_vector_type(4)));
    const i32x8 x = __builtin_shufflevector(__builtin_bit_cast(i32x4, b0), __builtin_bit_cast(i32x4, b1), 0, 1, 2, 3, 4, 5, 6, 7);
    const i32x8 y = __builtin_shufflevector(__builtin_bit_cast(i32x4, a0), __builtin_bit_cast(i32x4, a1), 0, 1, 2, 3, 4, 5, 6, 7);
    const int sw = 0x79797979, sa = 0x7f7f7f7f;
    asm volatile("v_mfma_scale_f32_16x16x128_f8f6f4 %0, %1, %2, %0, %3, %4 op_sel_hi:[0,0,0]" : "+v"(c) : "v"(x), "v"(y), "v"(sw), "v"(sa));
    return c;
}
#define PG8_MFMA_DRAIN() do { __builtin_amdgcn_sched_barrier(0); asm volatile("s_nop 7\n\ts_nop 7\n\ts_nop 7" ::: "memory"); __builtin_amdgcn_sched_barrier(0); } while (0)
struct EpiSwigluF8 {
    static constexpr bool PERM = true, AFTER_DRAIN = false;
    unsigned char* act; const float* bgu;
    typedef NoPre Pre; __device__ __forceinline__ void pre(Pre&, const Unit&, int, int, int, int) const {}
    __device__ __forceinline__ void operator()(const f32x4 (&acc)[2][2][4][2], const Unit& u, int wr, int wc, int fr, int fq, const Pre&) const {
        const int row0 = u.pm * BM + wr * 64 + fr, c0 = u.pn * HALF + wc * 32 + 8 * fq;
        const float* bg = bgu + (size_t)u.e * 2048 + c0;
        f32x4 bgv[2], buv[2];
#pragma unroll
        for (int n = 0; n < 2; ++n) { bgv[n] = *(const f32x4*)(bg + 4 * n); buv[n] = *(const f32x4*)(bg + 1024 + 4 * n); }
#pragma unroll
        for (int ai = 0; ai < 2; ++ai)
#pragma unroll
            for (int m = 0; m < 4; ++m) { float r[8];
#pragma unroll
                for (int n = 0; n < 2; ++n)
#pragma unroll
                    for (int j = 0; j < 4; ++j) { float g = acc[ai][0][m][n][j] + bgv[n][j], up = acc[ai][1][m][n][j] + buv[n][j];
                        g = fminf(g, 7.0f); up = fminf(fmaxf(up, -7.0f), 7.0f);
                        const float sg = __builtin_amdgcn_rcpf(1.0f + __expf(-1.702f * g)); r[4 * n + j] = (up + 1.0f) * g * sg; }
                typedef unsigned u32x2 __attribute__((ext_vector_type(2)));
                u32x2 w; w.x = pk4_fp8(r[0], r[1], r[2], r[3]); w.y = pk4_fp8(r[4], r[5], r[6], r[7]);
                *(u32x2*)(act + (size_t)(row0 + ai * HALF + m * 16) * 1024 + c0) = w; }
    }
};

template <class Epi, class Sched, bool ALIGN_EPI = false, bool SP2 = false, bool F8 = false, bool GATHER = false>
__device__ __forceinline__ void gemm_phase(PG8_LAS unsigned char* lds, const Gemm g, const Sched& S, const Epi& E) {
    const int tid = threadIdx.x, wid = __builtin_amdgcn_readfirstlane(tid >> 6), lane = tid & 63, wr = wid >> 2, wc = wid & 3, fr = lane & 15, fq = lane >> 4;
    const int K = g.K, RB = F8 ? K : 2 * K  , nt = RB / (BK * 2);
    unsigned voffA[2], voffB[2];
#pragma unroll
    for (int i = 0; i < 2; ++i) { int R, C; stage_rc(tid * 16 + i * 8192, R, C); const int Rb = Epi::PERM ? ((R & ~31) + perm32(R & 31)) : R;
        voffA[i] = (unsigned)(R * RB + C * 2); voffB[i] = (unsigned)(Rb * RB + C * 2); }
    const size_t kstep = (size_t)(BK * 2);
    const size_t hstep = (size_t)HALF * RB;
    const size_t tstep = 2 * hstep;
    const unsigned ldsw = (unsigned)wid * 1024u;
    const int aoff = lds_byte(wr * 64 + fr, fq * 8), boff = lds_byte(wc * 32 + fr, fq * 8);
#define PG8_SA(b, h) (((b) * 2 + (h)) * HTB)
#define PG8_SB(b, h) ((4 + (b) * 2 + (h)) * HTB)
#define PG8_STAGE(bufoff, gbase, voff) do { _Pragma("unroll") for (int _i = 0; _i < 2; ++_i) \
        __builtin_amdgcn_global_load_lds((const unsigned*)((const char*)(gbase) + (voff)[_i]), (PG8_LAS unsigned*)(lds + (bufoff) + ldsw + _i * 8192), 16, 0, 0); } while (0)
#define PG8_STAGE_A(bufoff, gbase, h, usenext) do { _Pragma("unroll") for (int _i = 0; _i < 2; ++_i) { \
        const unsigned _vo = GATHER ? ((usenext) ? nvA[h][_i] : cvA[h][_i]) : voffA[_i]; \
        __builtin_amdgcn_global_load_lds((const unsigned*)((const char*)(gbase) + (GATHER ? (size_t)0 : (size_t)(h) * hstep) + _vo), (PG8_LAS unsigned*)(lds + (bufoff) + ldsw + _i * 8192), 16, 0, 0); } } while (0)
#define PG8_LDA(dst, b, h) do { if (Sched::SPLIT && !((chm >> (h)) & 1)) break; _Pragma("unroll") for (int m = 0; m < 4; ++m) _Pragma("unroll") for (int k = 0; k < 2; ++k) dst[m][k] = *(const PG8_LAS bf16x8*)(lds + PG8_SA(b, h) + aoff + m * 2048 + k * 1024); } while (0)
#define PG8_LDB(dst, b, h) do { _Pragma("unroll") for (int n = 0; n < 2; ++n) _Pragma("unroll") for (int k = 0; k < 2; ++k) dst[n][k] = *(const PG8_LAS bf16x8*)(lds + PG8_SB(b, h) + boff + n * 2048 + k * 1024); } while (0)
#define PG8_MMA(ai, bj, At, Bt) do { if (Sched::SPLIT && !((chm >> (ai)) & 1)) break; __builtin_amdgcn_s_setprio(1); _Pragma("unroll") for (int m = 0; m < 4; ++m) _Pragma("unroll") for (int n = 0; n < 2; ++n) { \
        if constexpr (F8) { acc[ai][bj][m][n] = mma_f8(Bt[n][0], Bt[n][1], At[m][0], At[m][1], acc[ai][bj][m][n]); } \
        else { _Pragma("unroll") for (int k = 0; k < 2; ++k) acc[ai][bj][m][n] = __builtin_amdgcn_mfma_f32_16x16x32_bf16(Bt[n][k], At[m][k], acc[ai][bj][m][n], 0, 0, 0); } } \
        __builtin_amdgcn_s_setprio(0); } while (0)
#define PG8_WAIT_V(n) asm volatile("s_waitcnt vmcnt(" #n ")" ::: "memory")
#define PG8_WAIT_L(n) asm volatile("s_waitcnt lgkmcnt(" #n ")" ::: "memory")
#define PG8_BAR __builtin_amdgcn_s_barrier()
#define PG8_SCHED __builtin_amdgcn_sched_barrier(0)
    Unit cur, nxt; int ui = 0;
    if (!S.next(0, cur)) return;
    int chm = Sched::SPLIT ? __builtin_amdgcn_readfirstlane(cur.hm) : 3;
    f32x4 acc[2][2][4][2];
#pragma unroll
    for (int a = 0; a < 2; ++a)
#pragma unroll
        for (int b = 0; b < 2; ++b)
#pragma unroll
            for (int m = 0; m < 4; ++m)
#pragma unroll
                for (int n = 0; n < 2; ++n) acc[a][b][m][n] = (f32x4){0.f, 0.f, 0.f, 0.f};
    bf16x8 At[4][2], B0[2][2], B1[2][2];
    const char* cA = GATHER ? (const char*)g.A : (const char*)g.A + (size_t)cur.pm * tstep; const char* cB = (const char*)g.Bt + (size_t)cur.pb * (size_t)RB;
    unsigned cvA[2][2] = {{0u, 0u}, {0u, 0u}}, nvA[2][2] = {{0u, 0u}, {0u, 0u}};
    int gR[2] = {0, 0}, gC[2] = {0, 0};
    if constexpr (GATHER) {
#pragma unroll
        for (int i = 0; i < 2; ++i) stage_rc(tid * 16 + i * 8192, gR[i], gC[i]);
        { const int rr[4] = {gR[0], gR[1], HALF + gR[0], HALF + gR[1]}; unsigned ro[4]; S.row_off4(cur, rr, ro);
#pragma unroll
          for (int h = 0; h < 2; ++h)
#pragma unroll
              for (int i = 0; i < 2; ++i) cvA[h][i] = ro[2 * h + i] * (unsigned)RB + (unsigned)(gC[i] * 2); }
    }
    S.a_ready(cur);
    typename Epi::Pre epre; E.pre(epre, cur, wr, wc, fr, fq);
    if constexpr (SP2) {
        PG8_STAGE(PG8_SB(0, 0), cB, voffB); PG8_STAGE(PG8_SB(0, 1), cB + hstep, voffB); PG8_STAGE_A(PG8_SA(0, 0), cA, 0, false); PG8_STAGE_A(PG8_SA(0, 1), cA, 1, false);
        if (wr == 1) PG8_BAR;
        PG8_WAIT_V(2); PG8_BAR;
        PG8_STAGE(PG8_SB(1, 0), cB + kstep, voffB); PG8_STAGE_A(PG8_SA(1, 0), cA + kstep, 0, false); PG8_STAGE(PG8_SB(1, 1), cB + hstep + kstep, voffB);
        PG8_WAIT_V(6); PG8_BAR;
    } else {
        PG8_STAGE(PG8_SB(0, 0), cB, voffB); PG8_STAGE_A(PG8_SA(0, 0), cA, 0, false); PG8_STAGE(PG8_SB(0, 1), cB + hstep, voffB); PG8_STAGE_A(PG8_SA(0, 1), cA, 1, false);
        if (wr == 1) PG8_BAR;
        PG8_WAIT_V(4); PG8_BAR;
        PG8_STAGE(PG8_SB(1, 0), cB + kstep, voffB); PG8_STAGE_A(PG8_SA(1, 0), cA + kstep, 0, false); PG8_STAGE(PG8_SB(1, 1), cB + hstep + kstep, voffB);
        PG8_WAIT_V(6); PG8_BAR;
    }
    for (;;) {
        const bool has_next = S.next(ui + 1, nxt);
        const char* nA = GATHER ? cA : (has_next ? (const char*)g.A + (size_t)nxt.pm * tstep : cA); const char* nB = has_next ? (const char*)g.Bt + (size_t)nxt.pb * (size_t)RB : cB;
        if constexpr (GATHER) {
            if (has_next) { const int rr[4] = {gR[0], gR[1], HALF + gR[0], HALF + gR[1]}; unsigned ro[4]; S.row_off4(nxt, rr, ro);
#pragma unroll
                for (int h = 0; h < 2; ++h)
#pragma unroll
                    for (int i = 0; i < 2; ++i) nvA[h][i] = ro[2 * h + i] * (unsigned)RB + (unsigned)(gC[i] * 2); }
            else {
#pragma unroll
                for (int h = 0; h < 2; ++h)
#pragma unroll
                    for (int i = 0; i < 2; ++i) nvA[h][i] = cvA[h][i]; }
        }
        for (int t = 0; t < nt; t += 2) {
            const bool last = (t == nt - 2);
            const char* a1 = cA + (size_t)(t + 1) * kstep;
            const char* a2 = last ? nA : cA + (size_t)(t + 2) * kstep; const char* b2 = last ? nB : cB + (size_t)(t + 2) * kstep;
            const char* a3 = a2 + kstep; const char* b3 = b2 + kstep;
            if (last && has_next) S.a_ready(nxt);
            if constexpr (SP2) {
            PG8_LDB(B0, 0, 0); PG8_LDB(B1, 0, 1); PG8_SCHED; PG8_LDA(At, 0, 0); PG8_STAGE_A(PG8_SA(1, 1), a1, 1, false);
            PG8_WAIT_V(8); PG8_WAIT_L(0); PG8_BAR; PG8_MMA(0, 0, At, B0); PG8_MMA(0, 1, At, B1); PG8_BAR; PG8_SCHED;
            PG8_LDA(At, 0, 1); PG8_STAGE(PG8_SB(0, 0), b2, voffB); PG8_STAGE(PG8_SB(0, 1), b2 + hstep, voffB); PG8_STAGE_A(PG8_SA(0, 0), a2, 0, last);
            PG8_WAIT_V(8); PG8_WAIT_L(0); PG8_BAR; PG8_MMA(1, 0, At, B0); PG8_MMA(1, 1, At, B1); PG8_BAR; PG8_SCHED;
            PG8_LDB(B0, 1, 0); PG8_LDB(B1, 1, 1); PG8_SCHED; PG8_LDA(At, 1, 0); PG8_STAGE_A(PG8_SA(0, 1), a2, 1, last);
            PG8_WAIT_V(8); PG8_WAIT_L(0); PG8_BAR; PG8_MMA(0, 0, At, B0); PG8_MMA(0, 1, At, B1); PG8_BAR; PG8_SCHED;
            PG8_LDA(At, 1, 1); PG8_STAGE(PG8_SB(1, 0), b3, voffB); PG8_STAGE(PG8_SB(1, 1), b3 + hstep, voffB); PG8_STAGE_A(PG8_SA(1, 0), a3, 0, last);
            PG8_WAIT_V(8); PG8_WAIT_L(0); PG8_BAR; PG8_MMA(1, 0, At, B0); PG8_MMA(1, 1, At, B1); PG8_BAR; PG8_SCHED;
            } else {
            PG8_LDB(B0, 0, 0); PG8_SCHED; PG8_LDA(At, 0, 0); PG8_STAGE_A(PG8_SA(1, 1), a1, 1, false);
            PG8_WAIT_L(8); PG8_BAR; PG8_WAIT_L(0); PG8_MMA(0, 0, At, B0); PG8_BAR; PG8_SCHED;
            PG8_LDB(B1, 0, 1); PG8_STAGE(PG8_SB(0, 0), b2, voffB);
            PG8_BAR; PG8_WAIT_L(0); PG8_MMA(0, 1, At, B1); PG8_BAR;
            PG8_LDA(At, 0, 1); PG8_STAGE_A(PG8_SA(0, 0), a2, 0, last);
            PG8_BAR; PG8_WAIT_L(0); PG8_MMA(1, 0, At, B0); PG8_BAR; PG8_SCHED;
            PG8_STAGE(PG8_SB(0, 1), b2 + hstep, voffB);
            PG8_WAIT_V(6); PG8_BAR; PG8_MMA(1, 1, At, B1); PG8_BAR;
            PG8_LDB(B0, 1, 0); PG8_SCHED; PG8_LDA(At, 1, 0); PG8_STAGE_A(PG8_SA(0, 1), a2, 1, last);
            PG8_WAIT_L(8); PG8_BAR; PG8_WAIT_L(0); PG8_MMA(0, 0, At, B0); PG8_BAR; PG8_SCHED;
            PG8_LDB(B1, 1, 1); PG8_STAGE(PG8_SB(1, 0), b3, voffB);
            PG8_BAR; PG8_WAIT_L(0); PG8_MMA(0, 1, At, B1); PG8_BAR;
            PG8_LDA(At, 1, 1); PG8_STAGE_A(PG8_SA(1, 0), a3, 0, last);
            PG8_BAR; PG8_WAIT_L(0); PG8_MMA(1, 0, At, B0); PG8_BAR; PG8_SCHED;
            PG8_STAGE(PG8_SB(1, 1), b3 + hstep, voffB);
            PG8_WAIT_V(6); PG8_BAR; PG8_MMA(1, 1, At, B1); PG8_BAR;
            }
        }
        if constexpr (ALIGN_EPI) { if (wr == 0) PG8_BAR; }
        if constexpr (F8) { PG8_MFMA_DRAIN(); }
        if constexpr (!Epi::AFTER_DRAIN) { E(acc, cur, wr, wc, fr, fq, epre); S.done(cur); if (has_next) E.pre(epre, nxt, wr, wc, fr, fq); }
        if (!has_next) break;
#pragma unroll
        for (int a = 0; a < 2; ++a)
#pragma unroll
            for (int b = 0; b < 2; ++b)
#pragma unroll
                for (int m = 0; m < 4; ++m)
#pragma unroll
                    for (int n = 0; n < 2; ++n) acc[a][b][m][n] = (f32x4){0.f, 0.f, 0.f, 0.f};
        cur = nxt; cA = nA; cB = nB; ++ui; if (Sched::SPLIT) chm = __builtin_amdgcn_readfirstlane(cur.hm);
        if constexpr (GATHER) {
#pragma unroll
            for (int h = 0; h < 2; ++h)
#pragma unroll
                for (int i = 0; i < 2; ++i) cvA[h][i] = nvA[h][i];
        }
        if constexpr (ALIGN_EPI) { if (wr == 1) PG8_BAR; }
    }
    PG8_WAIT_V(0);
    if constexpr (!ALIGN_EPI) { if (wr == 0) PG8_BAR; }
    PG8_BAR;
    if constexpr (Epi::AFTER_DRAIN) { E.fused(acc, cur, wr, wc, fr, fq, lds, wid, lane); S.done(cur); }
#undef PG8_SA
#undef PG8_SB
#undef PG8_STAGE
#undef PG8_STAGE_A
#undef PG8_LDA
#undef PG8_LDB
#undef PG8_MMA
#undef PG8_WAIT_V
#undef PG8_WAIT_L
#undef PG8_BAR
#undef PG8_SCHED
}
}


constexpr int NWAVES = 8;
#ifndef MK_N_LAUNCHES
#define MK_N_LAUNCHES 1
#endif
constexpr int NPHASE = 11;
constexpr int N_LAUNCHES = MK_N_LAUNCHES;

constexpr int BATCH = 4, SEQ = 4096, D = 1024, NMETA = 16;
constexpr int M = BATCH * SEQ;
constexpr int INC = 4096;
constexpr int C_QA = 0, C_KA = 512, C_VA = 1024, C_QH = 1536, C_IH = 2048, C_FF = 2560, C_FB = 3072, C_GH = 3584;
constexpr int NE = 32, TOPK = 4;
constexpr float RMS_EPS = 1e-6f;
constexpr int XROWS_MAX = 73728;
constexpr int NTILE_MAX = 288;
constexpr int LCAP = 16384;

constexpr size_t MiB = 1u << 20;
constexpr size_t WS_CTL = 0, CTL_ZERO_BYTES = 65536;
constexpr size_t WS_WIN = 1 * MiB;
constexpr size_t WS_WOUT = 9 * MiB;
constexpr size_t WS_WGU = 11 * MiB;
constexpr size_t WS_WD = 139 * MiB;
constexpr size_t WS_XN = 203 * MiB;
constexpr size_t WS_R1 = 235 * MiB;
constexpr size_t WS_R2 = 395 * MiB;
constexpr size_t R2_HQ = 0, R2_HK = 32 * MiB, R2_HV = 64 * MiB, R2_HA = 96 * MiB, R2_HD = 112 * MiB, R2_META = 113 * MiB, R2_OF = 116 * MiB, R2_OB = 148 * MiB;
constexpr size_t WS_Y = 575 * MiB;
constexpr size_t WS_HMID = 607 * MiB;
constexpr size_t WS_XN2 = 671 * MiB;
constexpr size_t WS_LIST = 703 * MiB;
constexpr size_t WS_PROJM = 706 * MiB + 512 * 1024;
constexpr size_t WS_XNM = 706 * MiB + 768 * 1024;
constexpr size_t WS_WRT = 708 * MiB;
constexpr size_t WS_ROWSS = 709 * MiB;
constexpr size_t WS_END = 710 * MiB;
constexpr int HU_Q = 64 * 128, HU_K = 128 * 64, HU_V = 128 * 64, HU_A = 64 * 64, HU_D = 128;

constexpr int CW_TMO = 0, CW_CODE = 1;
constexpr int CW_CNT = 64;
constexpr int CW_BAR = 4096;

constexpr int RING_OFF = 0, RING_BYTES = 131072;
constexpr int LDSCTL_OFF = 155648, MISC_OFF = LDSCTL_OFF + 320;
constexpr int TILE_E_OFF = LDSCTL_OFF + 512;
constexpr int LDS_BYTES = 163840;
static_assert(TILE_E_OFF + (NTILE_MAX + 96) * 4 <= LDS_BYTES, "LDS map");
#define GAS __attribute__((address_space(1)))
#define LAS __attribute__((address_space(3)))
typedef unsigned short bf16;
typedef unsigned v4u __attribute__((ext_vector_type(4)));
typedef float f32x4 __attribute__((ext_vector_type(4)));
typedef short bf16x8 __attribute__((ext_vector_type(8)));
typedef GAS unsigned gu32;
typedef GAS unsigned long long gu64;
#define RLX_AGENT __ATOMIC_RELAXED, __HIP_MEMORY_SCOPE_AGENT
#define LDS_WAIT() asm volatile("s_waitcnt lgkmcnt(0)" ::: "memory")
#define VM_WAIT() asm volatile("s_waitcnt vmcnt(0)" ::: "memory")
__device__ __forceinline__ unsigned long long rt() { return __builtin_amdgcn_s_memrealtime(); }
__device__ __forceinline__ unsigned pk2(float lo, float hi) { typedef float f2_t_ __attribute__((ext_vector_type(2))); typedef __bf16 b2_t_ __attribute__((ext_vector_type(2))); f2_t_ v = {lo, hi}; b2_t_ b = __builtin_convertvector(v, b2_t_); return __builtin_bit_cast(unsigned, b); }
__device__ __forceinline__ unsigned f2bf(float f) { return pk2(f, f) & 0xffffu; }

#define XB_TMO      128
#define XB_XCNT(j)  (256  + 64 * (j))
#define XB_XSUB(j)  (1280 + 64 * (j))
#define XB_XGEN(j)  (2304 + 64 * (j))
#define XB_TOP      3328
#define XB_TOPGEN   3392
#define XCD_BAR_WORDS 3456
#define XB_SPIN_CAP (1u << 18)

__device__ __forceinline__ unsigned xb_ld(unsigned* p)              { return __hip_atomic_load(p, __ATOMIC_RELAXED, __HIP_MEMORY_SCOPE_AGENT); }
__device__ __forceinline__ unsigned xb_add(unsigned* p, unsigned v) { return __hip_atomic_fetch_add(p, v, __ATOMIC_RELAXED, __HIP_MEMORY_SCOPE_AGENT); }
__device__ __forceinline__ unsigned xb_xcc_id() { return (unsigned)__builtin_amdgcn_s_getreg((3 << 11) | 20) & 0xFu; }
#define XB_SPIN(cond, bar) do { unsigned _sp = 0; while (cond) { __builtin_amdgcn_s_sleep(1); \
    if ((++_sp & 255u) == 0u) { if (xb_ld(&(bar)[XB_TMO])) break; if (_sp > XB_SPIN_CAP) { atomicAdd(&(bar)[XB_TMO], 1u); break; } } } } while (0)

struct XcdBarrier {
    unsigned* bar; unsigned x;
    volatile LAS unsigned* st;
};

__device__ __forceinline__ XcdBarrier xcd_barrier_post(unsigned* bar, volatile LAS unsigned* st) {
    XcdBarrier b; b.bar = bar; b.x = xb_xcc_id(); b.st = st;
    if (threadIdx.x == 0) (void)xb_add(&bar[XB_XCNT(b.x)], 1u);
    return b;
}
__device__ __forceinline__ void xcd_barrier_complete(unsigned* bar, unsigned x, unsigned& nloc, unsigned& nx) {
    const unsigned G = gridDim.x * gridDim.y * gridDim.z;
    unsigned sum, cnt, mine, sp = 0u;
    for (;;) {
        sum = 0u; cnt = 0u; mine = 0u;
#pragma unroll
        for (unsigned j = 0; j < 16; ++j) { const unsigned c = xb_ld(&bar[XB_XCNT(j)]); sum += c; cnt += (c > 0u) ? 1u : 0u; mine = (j == x) ? c : mine; }
        if (sum == G) break;
        __builtin_amdgcn_s_sleep(1);
        if ((++sp & 255u) == 0u) { if (xb_ld(&bar[XB_TMO])) break; if (sp > XB_SPIN_CAP) { atomicAdd(&bar[XB_TMO], 1u); break; } }
    }
    nloc = mine > 0u ? mine : 1u; nx = cnt > 0u ? cnt : 1u;
}

__device__ __forceinline__ void xcd_barrier(const XcdBarrier& b) {
    asm volatile("s_waitcnt vmcnt(0)" ::: "memory");
    __syncthreads();
    if (threadIdx.x == 0) {
        unsigned* bar = b.bar;
        __builtin_amdgcn_s_waitcnt(0);
        unsigned nloc = b.st[0], nx = b.st[1];
        if (nloc == 0u) { xcd_barrier_complete(bar, b.x, nloc, nx); b.st[0] = nloc; b.st[1] = nx; }
        const unsigned old = xb_add(&bar[XB_XSUB(b.x)], 1u);
        const unsigned gen = old / nloc;
        if (old + 1u == (gen + 1u) * nloc) {
            __builtin_amdgcn_fence(__ATOMIC_RELEASE, "agent");
            asm volatile("s_waitcnt vmcnt(0)" ::: "memory");
            const unsigned og = xb_add(&bar[XB_TOP], 1u);
            const unsigned tg = og / nx;
            if (og + 1u == (tg + 1u) * nx) xb_add(&bar[XB_TOPGEN], 1u);
            else XB_SPIN(xb_ld(&bar[XB_TOPGEN]) == tg, bar);
            __builtin_amdgcn_fence(__ATOMIC_ACQUIRE, "agent");
            xb_add(&bar[XB_XGEN(b.x)], 1u);
            asm volatile("s_waitcnt vmcnt(0)" ::: "memory");
        } else {
            XB_SPIN(xb_ld(&bar[XB_XGEN(b.x)]) == gen, bar);
            __builtin_amdgcn_fence(__ATOMIC_ACQUIRE, "agent");
            asm volatile("s_waitcnt vmcnt(0)" ::: "memory");
        }
    }
    __syncthreads();
}


typedef unsigned v2u __attribute__((ext_vector_type(2)));
typedef float f32x2 __attribute__((ext_vector_type(2)));
struct Frame {
    LAS unsigned char* lds;
    volatile LAS unsigned* MISC;
    gu32* ctl;
    int tid, lane, wave;
    int vcu, G;
    const float* in[17];
    float* out;
    unsigned char* ws;
};
__device__ __forceinline__ float bf2f(unsigned short h) { return __builtin_bit_cast(float, (unsigned)h << 16); }
__device__ __forceinline__ float bflo(unsigned w) { return __builtin_bit_cast(float, w << 16); }
__device__ __forceinline__ float bfhi(unsigned w) { return __builtin_bit_cast(float, w & 0xffff0000u); }
__device__ __forceinline__ float sigmoidf_(float x) { return __builtin_amdgcn_rcpf(1.0f + __expf(-x)); }
__device__ __forceinline__ float wave_sum(float v) {
#pragma unroll
    for (int o = 1; o < 64; o <<= 1) v += __shfl_xor(v, o);
    return v;
}
__device__ __forceinline__ f32x4 mfma16(bf16x8 a, bf16x8 b, f32x4 c) { return __builtin_amdgcn_mfma_f32_16x16x32_bf16(a, b, c, 0, 0, 0); }

__device__ __forceinline__ void p0_transpose_item(const float* W, int K, int N, bf16* WT, LAS float* scr, int item, int lane) {
    const int nblk = N / 32, kb = item / nblk, nb = item % nblk, k0 = 128 * kb, n0 = 32 * nb;
    const float* src = W + (size_t)(k0 + (lane >> 3)) * N + n0 + 4 * (lane & 7);
    f32x4 v[16];
#pragma unroll
    for (int i = 0; i < 16; ++i) v[i] = *(const GAS f32x4*)(src + (size_t)(8 * i) * N);
#pragma unroll
    for (int i = 0; i < 16; ++i) { LAS float* d = scr + (8 * i + (lane >> 3)) * 33 + 4 * (lane & 7); d[0] = v[i].x; d[1] = v[i].y; d[2] = v[i].z; d[3] = v[i].w; }
    LDS_WAIT(); asm volatile("" ::: "memory");
    const int c = lane & 15;
#pragma unroll
    for (int j = 0; j < 8; ++j) { const int n = (lane >> 4) + 4 * j; const LAS float* s = scr + (8 * c) * 33 + n;
        v4u o; o.x = pk2(s[0 * 33], s[1 * 33]); o.y = pk2(s[2 * 33], s[3 * 33]); o.z = pk2(s[4 * 33], s[5 * 33]); o.w = pk2(s[6 * 33], s[7 * 33]);
        *(GAS v4u*)(WT + (size_t)(n0 + n) * K + k0 + 8 * c) = o; }
    LDS_WAIT(); asm volatile("" ::: "memory");
}
template <bool GU>
__device__ __forceinline__ void p0_transpose_item_f8(const float* W, int K, int N, unsigned char* WT, LAS float* scr, int item, int lane) {
    const int nblk = N / 32, kb = item / nblk, nb = item % nblk, k0 = 128 * kb, n0 = 32 * nb;
    int d0 = n0;
    if (GU) { const int c = n0 & 1023, up = n0 >> 10; d0 = (c >> 7) * 256 + up * 128 + (c & 127); }
    const float* src = W + (size_t)(k0 + (lane >> 3)) * N + n0 + 4 * (lane & 7);
    f32x4 v[16];
#pragma unroll
    for (int i = 0; i < 16; ++i) v[i] = __builtin_nontemporal_load((const GAS f32x4*)(src + (size_t)(8 * i) * N));
#pragma unroll
    for (int i = 0; i < 16; ++i) { LAS float* d = scr + (8 * i + (lane >> 3)) * 33 + 4 * (lane & 7); d[0] = v[i].x; d[1] = v[i].y; d[2] = v[i].z; d[3] = v[i].w; }
    LDS_WAIT(); asm volatile("" ::: "memory");
    const int c = lane & 15;
    constexpr float S = pg8::W8_SCALE;
#pragma unroll
    for (int j = 0; j < 8; ++j) { const int n = (lane >> 4) + 4 * j; const LAS float* s = scr + (8 * c) * 33 + n;
        v2u o; o.x = pg8::pk4_fp8(s[0 * 33] * S, s[1 * 33] * S, s[2 * 33] * S, s[3 * 33] * S); o.y = pg8::pk4_fp8(s[4 * 33] * S, s[5 * 33] * S, s[6 * 33] * S, s[7 * 33] * S);
        if (GU) __builtin_nontemporal_store(o, (GAS v2u*)(WT + (size_t)(d0 + n) * K + k0 + 8 * c));
        else *(GAS v2u*)(WT + (size_t)(d0 + n) * K + k0 + 8 * c) = o; }
    LDS_WAIT(); asm volatile("" ::: "memory");
}
__device__ __forceinline__ void conv_item_issue(const float* W, int N, int item, int lane, f32x4 (&v)[16]) {
    const int nblk = N / 32, kb = item / nblk, nb = item % nblk, k0 = 128 * kb, n0 = 32 * nb;
    const float* src = W + (size_t)(k0 + (lane >> 3)) * N + n0 + 4 * (lane & 7);
#pragma unroll
    for (int i = 0; i < 16; ++i) v[i] = __builtin_nontemporal_load((const GAS f32x4*)(src + (size_t)(8 * i) * N));
}
__device__ __forceinline__ void conv_item_finish(int K, int N, unsigned char* WT, LAS float* scr, int item, int lane, const f32x4 (&v)[16]) {
    const int nblk = N / 32, kb = item / nblk, nb = item % nblk, k0 = 128 * kb, n0 = 32 * nb;
#pragma unroll
    for (int i = 0; i < 16; ++i) { LAS float* d = scr + (8 * i + (lane >> 3)) * 33 + 4 * (lane & 7); d[0] = v[i].x; d[1] = v[i].y; d[2] = v[i].z; d[3] = v[i].w; }
    LDS_WAIT(); asm volatile("" ::: "memory");
    const int c = lane & 15;
    constexpr float S = pg8::W8_SCALE;
#pragma unroll
    for (int j = 0; j < 8; ++j) { const int n = (lane >> 4) + 4 * j; const LAS float* s = scr + (8 * c) * 33 + n;
        v2u o; o.x = pg8::pk4_fp8(s[0 * 33] * S, s[1 * 33] * S, s[2 * 33] * S, s[3 * 33] * S); o.y = pg8::pk4_fp8(s[4 * 33] * S, s[5 * 33] * S, s[6 * 33] * S, s[7 * 33] * S);
        *(GAS v2u*)(WT + (size_t)(n0 + n) * K + k0 + 8 * c) = o; }
    LDS_WAIT(); asm volatile("" ::: "memory");
}
__device__ __forceinline__ void rms_row_to_bf16(int lane, const float* xrow, const f32x4 (&gg)[4], bf16* orow) {
    const GAS f32x4* xr = (const GAS f32x4*)xrow + lane;
    f32x4 v[4]; float s = 0.f;
#pragma unroll
    for (int j = 0; j < 4; ++j) { v[j] = xr[64 * j]; s += (v[j].x * v[j].x + v[j].y * v[j].y) + (v[j].z * v[j].z + v[j].w * v[j].w); }
    const float rstd = __builtin_amdgcn_rsqf(wave_sum(s) * (1.f / D) + RMS_EPS);
    GAS unsigned long long* o8 = (GAS unsigned long long*)orow + lane;
#pragma unroll
    for (int j = 0; j < 4; ++j)
        o8[64 * j] = (unsigned long long)pk2(v[j].x * rstd * gg[j].x, v[j].y * rstd * gg[j].y) | ((unsigned long long)pk2(v[j].z * rstd * gg[j].z, v[j].w * rstd * gg[j].w) << 32);
}
__device__ __forceinline__ void p0_prologue(Frame& F) {
    LAS float* scr = (LAS float*)(F.lds + RING_OFF + F.wave * 16896);
    const int gw = F.vcu * NWAVES + F.wave, NGW = F.G * NWAVES;
    bf16* Win_t = (bf16*)(F.ws + WS_WIN); bf16* Wout_t = (bf16*)(F.ws + WS_WOUT);
    constexpr int I_IN = (D / 128) * (INC / 32), I_OUT = (D / 128) * (D / 32);
    for (int it = gw; it < I_IN + I_OUT; it += NGW) {
        if (it < I_IN) p0_transpose_item(F.in[3], D, INC, Win_t, scr, it, F.lane);
        else p0_transpose_item(F.in[8], D, D, Wout_t, scr, it - I_IN, F.lane);
    }
    bf16* XN = (bf16*)(F.ws + WS_XN);
    f32x4 gg[4];
#pragma unroll
    for (int j = 0; j < 4; ++j) gg[j] = ((const GAS f32x4*)F.in[2] + F.lane)[64 * j];
    for (int m = gw; m < M; m += NGW) rms_row_to_bf16(F.lane, F.in[0] + (size_t)m * D, gg, XN + (size_t)m * D);
    { bf16* WrT = (bf16*)(F.ws + WS_WRT); const float* Wr = F.in[10];
      for (int idx = gw * 64 + F.lane; idx < NE * D; idx += NGW * 64) { const int e = idx >> 10, k = idx & 1023; const float w = Wr[k * NE + e];
          const unsigned short hi = (unsigned short)f2bf(w); WrT[idx] = hi; WrT[NE * D + idx] = (unsigned short)f2bf(w - bf2f(hi)); } }
    if (gw >= NGW - NMETA) { const int r = gw - (NGW - NMETA); rms_row_to_bf16(F.lane, F.in[1] + (size_t)r * D, gg, (bf16*)(F.ws + WS_XNM) + (size_t)r * D); }
}
constexpr int CW_CONV = 128, CW_SCAN_DONE = 256;
template <bool PIPE>
__device__ __forceinline__ void p3_convert(Frame& F, int ctr, int part) {
    LAS float* scr = (LAS float*)(F.lds + RING_OFF + F.wave * 16896);
    LAS int* bsh = (LAS int*)(F.lds + TILE_E_OFF + 2048);
    unsigned char* Wgu_t = F.ws + WS_WGU; unsigned char* Wd_t = F.ws + WS_WD;
    constexpr int I_GU = (D / 128) * (2048 / 32), I_DN = (D / 128) * (D / 32);
    const int NITEMS = part == 0 ? NE * I_GU : NE * I_DN;
    for (;;) {
        __syncthreads();
        if (F.tid == 0) bsh[0] = (int)__hip_atomic_fetch_add(F.ctl + CW_CONV + ctr, 64u, RLX_AGENT);
        __syncthreads();
        const int base = bsh[0];
        if (base >= NITEMS) break;
        if constexpr (PIPE) {
            const float* Wd = F.in[14]; f32x4 va[16], vb[16];
            { const int r = base + F.wave; conv_item_issue(Wd + (size_t)(r / I_DN) * D * D, D, r % I_DN, F.lane, va); }
#pragma unroll 1
            for (int ii = 0; ii < 4; ++ii) {
                const int ra = base + (2 * ii) * 8 + F.wave, rbb = ra + 8, rc = ra + 16;
                conv_item_issue(Wd + (size_t)(rbb / I_DN) * D * D, D, rbb % I_DN, F.lane, vb);
                conv_item_finish(D, D, Wd_t + (size_t)(ra / I_DN) * D * D, scr, ra % I_DN, F.lane, va);
                if (ii < 3) conv_item_issue(Wd + (size_t)(rc / I_DN) * D * D, D, rc % I_DN, F.lane, va);
                conv_item_finish(D, D, Wd_t + (size_t)(rbb / I_DN) * D * D, scr, rbb % I_DN, F.lane, vb);
            }
        } else
#pragma unroll 1
        for (int i = 0; i < 8; ++i) {
            const int r = base + i * 8 + F.wave; if (r >= NITEMS) break;
            if (part == 0) { const int e = r / I_GU; p0_transpose_item_f8<true>(F.in[12] + (size_t)e * D * 2048, D, 2048, Wgu_t + (size_t)e * 2048 * D, scr, r % I_GU, F.lane); }
            else { const int e = r / I_DN; p0_transpose_item_f8<false>(F.in[14] + (size_t)e * D * D, D, D, Wd_t + (size_t)e * D * D, scr, r % I_DN, F.lane); }
        }
    }
    __syncthreads();
}

__device__ __forceinline__ void p1_meta_proj(Frame& F) {
    LAS f32x4* part = (LAS f32x4*)(F.lds + RING_OFF);
    const bf16* XNM = (const bf16*)(F.ws + WS_XNM); const bf16* Wt = (const bf16*)(F.ws + WS_WIN); bf16* PM = (bf16*)(F.ws + WS_PROJM);
    const int lane = F.lane, qi = lane & 15, G = lane >> 4, w = F.wave;
    for (int t = blockIdx.x; t < INC / 16; t += F.G) {
        f32x4 acc = {0.f, 0.f, 0.f, 0.f};
        bf16x8 a[4], b[4];
#pragma unroll
        for (int s = 0; s < 4; ++s) { const int k0 = 128 * w + 32 * s + 8 * G;
            a[s] = *(const GAS bf16x8*)(XNM + (size_t)qi * D + k0); b[s] = *(const GAS bf16x8*)(Wt + (size_t)(16 * t + qi) * D + k0); }
#pragma unroll
        for (int s = 0; s < 4; ++s) acc = mfma16(a[s], b[s], acc);
        __syncthreads();
        part[w * 64 + lane] = acc;
        __syncthreads();
        if (w == 0) { f32x4 v = part[lane];
#pragma unroll
            for (int i = 1; i < 8; ++i) v += part[i * 64 + lane];
#pragma unroll
            for (int r = 0; r < 4; ++r) PM[(size_t)(4 * G + r) * INC + 16 * t + qi] = (unsigned short)f2bf(v[r]); }
    }
    __syncthreads();
}

typedef short v4s __attribute__((ext_vector_type(4)));
constexpr int NA_KRING = 0, NA_VRING = 73728, NA_MK = 147456, NA_MV = 149504;
__device__ __forceinline__ v4s na_tr16(const LAS unsigned char* p) { return __builtin_amdgcn_ds_read_tr16_b64_v4i16((LAS v4s*)p); }
__device__ __forceinline__ int na_rs(int r) { const int x = r - 4; return x < 0 ? 0 : (x > 56 ? 56 : x); }
__device__ __forceinline__ void p2_natten(Frame& F) {
    LAS float* rpbL = (LAS float*)(F.lds + NA_MV + 2048);
    static_assert(NA_MV + 2048 + 15 * 31 * 4 <= LDSCTL_OFF, "NA LDS map");
    const bf16* P = (const bf16*)(F.ws + WS_R1); const bf16* PM = (const bf16*)(F.ws + WS_PROJM);
    bf16* Y = (bf16*)(F.ws + WS_Y); const float* gna = F.in[5];
    const int lane = F.lane, qi = lane & 15, G = lane >> 4, w = F.wave, tid = F.tid;
    const int skey = tid >> 3, schunk = tid & 7;
    const int sdst = skey * 128 + ((schunk ^ (skey & 7)) << 4);
    const f32x4 z4 = {0.f, 0.f, 0.f, 0.f};
    for (int unit = F.vcu; unit < BATCH * 8 * 8; unit += F.G) {
        const int R = unit & 7, h = (unit >> 3) & 7, b = unit >> 6;
        const bf16* Pk = P + (size_t)(b * SEQ) * INC + C_KA + h * 64 + schunk * 8;
        __syncthreads();
        v4u mreg = {0u, 0u, 0u, 0u}; float r3[3] = {0.f, 0.f, 0.f};
        const int t2 = tid & 127, k2 = t2 >> 3, c2 = t2 & 7;
        if (tid < 256) mreg = *(const GAS v4u*)(PM + (size_t)k2 * INC + (tid < 128 ? C_KA : C_VA) + h * 64 + c2 * 8);
        else if (tid < 256 + 155) { const int i0 = (tid - 256) * 3;
#pragma unroll
            for (int i = 0; i < 3; ++i) r3[i] = F.in[4][h * 465 + i0 + i]; }
        int hi = na_rs(8 * R + 1) + 7;
        { const int lo = na_rs(8 * R);
          v4u kr[9], vr[9];
#pragma unroll
          for (int i = 0; i < 9; ++i) { const int row = lo + i <= hi ? lo + i : hi; const bf16* src = Pk + (size_t)(row * 64 + skey) * INC; kr[i] = *(const GAS v4u*)(src); vr[i] = *(const GAS v4u*)(src + (C_VA - C_KA)); }
#pragma unroll
          for (int i = 0; i < 9; ++i) { const int row = lo + i <= hi ? lo + i : hi; const int slot = row % 9;
              *(LAS v4u*)(F.lds + NA_KRING + slot * 8192 + sdst) = kr[i]; *(LAS v4u*)(F.lds + NA_VRING + slot * 8192 + sdst) = vr[i]; } }
        if (tid < 256) *(LAS v4u*)(F.lds + (tid < 128 ? NA_MK : NA_MV) + k2 * 128 + ((c2 ^ (k2 & 7)) << 4)) = mreg;
        else if (tid < 256 + 155) { const int i0 = (tid - 256) * 3;
#pragma unroll
            for (int i = 0; i < 3; ++i) rpbL[i0 + i] = r3[i]; }
        const int g = w & 3, cs0 = g == 0 ? 0 : (g == 1 ? 8 : (g == 2 ? 24 : 32));
        const int c = 16 * g + qi; int csq = c - 8; csq = csq < 0 ? 0 : (csq > 48 ? 48 : csq);
        const int kofs = (cs0 + qi) * 128, kx = qi & 7;
        const int vkey = cs0 + 4 * G + (qi >> 2), vx = (4 * (G & 1) + (qi >> 2)) & 7, vp = qi & 3;
        f32x4 gq[4];
#pragma unroll
        for (int dt = 0; dt < 4; ++dt) gq[dt] = *(const GAS f32x4*)(gna + h * 64 + 16 * dt + 4 * G);
        bf16x8 qf0, qf1;
        { const bf16* qp = P + (size_t)(b * SEQ + (8 * R + (w >> 2)) * 64 + c) * INC + C_QA + h * 64 + 8 * G; qf0 = *(const GAS bf16x8*)(qp); qf1 = *(const GAS bf16x8*)(qp + 32); }
        __syncthreads();
#pragma unroll 1
        for (int s = 0; s < 4; ++s) {
            const int r0 = 8 * R + 2 * s, r = r0 + (w >> 2), rs = na_rs(r);
            v4u kpre[2], vpre[2]; bf16x8 nq0 = qf0, nq1 = qf1; int nnew = 0;
            if (s < 3) {
                const int nhi = na_rs(r0 + 3) + 7; nnew = nhi - hi;
#pragma unroll
                for (int i = 0; i < 2; ++i) if (i < nnew) { const bf16* src = Pk + (size_t)((hi + 1 + i) * 64 + skey) * INC; kpre[i] = *(const GAS v4u*)(src); vpre[i] = *(const GAS v4u*)(src + (C_VA - C_KA)); }
                const bf16* qp = P + (size_t)(b * SEQ + (r + 2) * 64 + c) * INC + C_QA + h * 64 + 8 * G; nq0 = *(const GAS bf16x8*)(qp); nq1 = *(const GAS bf16x8*)(qp + 32);
            }
            f32x4 st[8][2], sm;
            bf16x8 kc[4], kn[4];
            { const LAS unsigned char* kb = F.lds + NA_KRING + (rs % 9) * 8192 + kofs;
              kc[0] = *(const LAS bf16x8*)(kb + ((G ^ kx) << 4)); kc[1] = *(const LAS bf16x8*)(kb + (((4 + G) ^ kx) << 4));
              kc[2] = *(const LAS bf16x8*)(kb + 2048 + ((G ^ kx) << 4)); kc[3] = *(const LAS bf16x8*)(kb + 2048 + (((4 + G) ^ kx) << 4)); }
#pragma unroll
            for (int i = 0; i < 8; ++i) {
                if (i < 7) { const LAS unsigned char* kb = F.lds + NA_KRING + ((rs + i + 1) % 9) * 8192 + kofs;
                    kn[0] = *(const LAS bf16x8*)(kb + ((G ^ kx) << 4)); kn[1] = *(const LAS bf16x8*)(kb + (((4 + G) ^ kx) << 4));
                    kn[2] = *(const LAS bf16x8*)(kb + 2048 + ((G ^ kx) << 4)); kn[3] = *(const LAS bf16x8*)(kb + 2048 + (((4 + G) ^ kx) << 4)); }
                else { const LAS unsigned char* kb = F.lds + NA_MK + qi * 128;
                    kn[0] = *(const LAS bf16x8*)(kb + ((G ^ kx) << 4)); kn[1] = *(const LAS bf16x8*)(kb + (((4 + G) ^ kx) << 4)); kn[2] = kn[0]; kn[3] = kn[1]; }
                st[i][0] = mfma16(kc[0], qf0, z4); st[i][1] = mfma16(kc[2], qf0, z4);
                st[i][0] = mfma16(kc[1], qf1, st[i][0]); st[i][1] = mfma16(kc[3], qf1, st[i][1]);
#pragma unroll
                for (int q = 0; q < 4; ++q) kc[q] = kn[q];
            }
            sm = mfma16(kc[0], qf0, z4); sm = mfma16(kc[1], qf1, sm);
            float mx = -1e30f;
#pragma unroll
            for (int n = 0; n < 2; ++n)
#pragma unroll
                for (int j = 0; j < 4; ++j) {
                    const int cc = cs0 + 16 * n + 4 * G + j; const bool valid = (cc >= csq) && (cc < csq + 16); const int dc = cc - c + 15;
                    const LAS float* bp = rpbL + (rs - r + 7) * 31 + (valid ? dc : 0);
                    float bv[8];
#pragma unroll
                    for (int i = 0; i < 8; ++i) bv[i] = bp[i * 31];
#pragma unroll
                    for (int i = 0; i < 8; ++i) { const float tv = st[i][n][j] * 0.125f + bv[i]; const float sv = valid ? tv : -1e30f; st[i][n][j] = sv; mx = fmaxf(mx, sv); }
                }
#pragma unroll
            for (int j = 0; j < 4; ++j) { sm[j] *= 0.125f; mx = fmaxf(mx, sm[j]); }
            mx = fmaxf(mx, __shfl_xor(mx, 16)); mx = fmaxf(mx, __shfl_xor(mx, 32));
            float sum = 0.f;
#pragma unroll
            for (int i = 0; i < 8; ++i)
#pragma unroll
                for (int n = 0; n < 2; ++n)
#pragma unroll
                    for (int j = 0; j < 4; ++j) { const float p = __expf(st[i][n][j] - mx); st[i][n][j] = p; sum += p; }
#pragma unroll
            for (int j = 0; j < 4; ++j) { const float p = __expf(sm[j] - mx); sm[j] = p; sum += p; }
            sum += __shfl_xor(sum, 16); sum += __shfl_xor(sum, 32);
            f32x4 o[4] = {z4, z4, z4, z4};
            bf16x8 vc[4], vn[4];
            { const LAS unsigned char* vb = F.lds + NA_VRING + (rs % 9) * 8192 + vkey * 128 + 8 * (vp & 1);
#pragma unroll
              for (int dt = 0; dt < 4; ++dt) { const int co = ((2 * dt + (vp >> 1)) ^ vx) << 4; const v4s lo = na_tr16(vb + co), hi4 = na_tr16(vb + 2048 + co);
                  vc[dt] = (bf16x8){lo[0], lo[1], lo[2], lo[3], hi4[0], hi4[1], hi4[2], hi4[3]}; } }
#pragma unroll
            for (int i = 0; i < 8; ++i) {
                if (i < 7) { const LAS unsigned char* vb = F.lds + NA_VRING + ((rs + i + 1) % 9) * 8192 + vkey * 128 + 8 * (vp & 1);
#pragma unroll
                    for (int dt = 0; dt < 4; ++dt) { const int co = ((2 * dt + (vp >> 1)) ^ vx) << 4; const v4s lo = na_tr16(vb + co), hi4 = na_tr16(vb + 2048 + co);
                        vn[dt] = (bf16x8){lo[0], lo[1], lo[2], lo[3], hi4[0], hi4[1], hi4[2], hi4[3]}; } }
                else { const int mkey = 4 * G + (qi >> 2); const LAS unsigned char* vb = F.lds + NA_MV + mkey * 128 + 8 * (vp & 1);
#pragma unroll
                    for (int dt = 0; dt < 4; ++dt) { const v4s lo = na_tr16(vb + (((2 * dt + (vp >> 1)) ^ (mkey & 7)) << 4)); vn[dt] = (bf16x8){lo[0], lo[1], lo[2], lo[3], 0, 0, 0, 0}; } }
                bf16x8 pf; { v4u wv; wv.x = pk2(st[i][0][0], st[i][0][1]); wv.y = pk2(st[i][0][2], st[i][0][3]); wv.z = pk2(st[i][1][0], st[i][1][1]); wv.w = pk2(st[i][1][2], st[i][1][3]); pf = __builtin_bit_cast(bf16x8, wv); }
#pragma unroll
                for (int dt = 0; dt < 4; ++dt) o[dt] = mfma16(vc[dt], pf, o[dt]);
#pragma unroll
                for (int dt = 0; dt < 4; ++dt) vc[dt] = vn[dt];
            }
            { bf16x8 pf; { v4u wv; wv.x = pk2(sm[0], sm[1]); wv.y = pk2(sm[2], sm[3]); wv.z = 0u; wv.w = 0u; pf = __builtin_bit_cast(bf16x8, wv); }
#pragma unroll
              for (int dt = 0; dt < 4; ++dt) o[dt] = mfma16(vc[dt], pf, o[dt]); }
            const float inv = __builtin_amdgcn_rcpf(sum); float q2 = 0.f;
#pragma unroll
            for (int dt = 0; dt < 4; ++dt)
#pragma unroll
                for (int j = 0; j < 4; ++j) { o[dt][j] *= inv; q2 += o[dt][j] * o[dt][j]; }
            q2 += __shfl_xor(q2, 16); q2 += __shfl_xor(q2, 32);
            const float rn = __builtin_amdgcn_rsqf(q2 * (1.0f / 64.0f) + RMS_EPS);
            bf16* yp = Y + (size_t)(b * SEQ + r * 64 + c) * D + h * 64 + 4 * G;
#pragma unroll
            for (int dt = 0; dt < 4; ++dt) { const f32x4 gg = gq[dt];
                v2u wv; wv.x = pk2(o[dt][0] * rn * gg.x, o[dt][1] * rn * gg.y); wv.y = pk2(o[dt][2] * rn * gg.z, o[dt][3] * rn * gg.w);
                *(GAS v2u*)(yp + 16 * dt) = wv; }
            __syncthreads();
            if (s < 3) {
#pragma unroll
                for (int i = 0; i < 2; ++i) if (i < nnew) { const int slot = (hi + 1 + i) % 9;
                    *(LAS v4u*)(F.lds + NA_KRING + slot * 8192 + sdst) = kpre[i]; *(LAS v4u*)(F.lds + NA_VRING + slot * 8192 + sdst) = vpre[i]; }
                hi += nnew; qf0 = nq0; qf1 = nq1;
            }
            __syncthreads();
        }
    }
    __syncthreads();
}

constexpr int HP_PK = 72, HP_PX = 24;
constexpr int HP_QS = 0, HP_KD = 18432, HP_KE = 36864, HP_QT = 55296, HP_QX = 73728, HP_HA = 92160, HP_TS = 101376;
typedef unsigned short us16 __attribute__((ext_vector_type(16)));
__device__ __forceinline__ unsigned cvtpk(float lo, float hi) { typedef float f2_t __attribute__((ext_vector_type(2))); typedef __bf16 b2_t __attribute__((ext_vector_type(2))); f2_t v = {lo, hi}; b2_t b = __builtin_convertvector(v, b2_t); return __builtin_bit_cast(unsigned, b); }
template <bool REV> __device__ __forceinline__ void pack16(const float (&x)[16], v4u& a, v4u& b) {
    if (!REV) { a.x = cvtpk(x[0], x[1]); a.y = cvtpk(x[2], x[3]); a.z = cvtpk(x[4], x[5]); a.w = cvtpk(x[6], x[7]); b.x = cvtpk(x[8], x[9]); b.y = cvtpk(x[10], x[11]); b.z = cvtpk(x[12], x[13]); b.w = cvtpk(x[14], x[15]); }
    else { a.x = cvtpk(x[15], x[14]); a.y = cvtpk(x[13], x[12]); a.z = cvtpk(x[11], x[10]); a.w = cvtpk(x[9], x[8]); b.x = cvtpk(x[7], x[6]); b.y = cvtpk(x[5], x[4]); b.z = cvtpk(x[3], x[2]); b.w = cvtpk(x[1], x[0]); }
}
template <bool REV>
__device__ __forceinline__ void hprep_dir(Frame& F, const float (&gl)[16], const float (&kk)[16], const float (&qq)[16], const unsigned short (&vv)[16], int dslot,
                                          bf16* HQ, bf16* HK, bf16* HV, bf16* HA, float* HDp) {
    LAS unsigned char* L = F.lds + RING_OFF;
    LAS float* Tsh = (LAS float*)(L + HP_TS) + dslot * 512;
    const int k = F.tid & 127, i = F.tid >> 7, ic = REV ? 3 - i : i;
    float bl[16];
    if (!REV) { float run = 0.f;
#pragma unroll
        for (int tt = 0; tt < 16; ++tt) { run += gl[tt]; bl[tt] = run; } }
    else { float run = 0.f;
#pragma unroll
        for (int tt = 15; tt >= 0; --tt) { run += gl[tt]; bl[tt] = run; } }
    const float Ti = REV ? bl[0] : bl[15];
    Tsh[ic * 128 + k] = Ti;
    __syncthreads();
    const float T0 = Tsh[k], T1 = Tsh[128 + k], T2 = Tsh[256 + k], T3 = Tsh[384 + k];
    const float Ei = ic == 0 ? 0.f : (ic == 1 ? T0 : (ic == 2 ? T0 + T1 : T0 + T1 + T2));
    const float Af = ic == 0 ? T1 + T2 + T3 : (ic == 1 ? T2 + T3 : (ic == 2 ? T3 : 0.f));
    const float eE = __expf(Ei), eA = __expf(Af), eT = __expf(Ti);
    const float x0 = __expf(ic == 2 ? T1 : T2), x1 = __expf(T1 + T2);
    float qs[16], kd[16], ke[16], qt[16], kh[16];
#pragma unroll
    for (int tt = 0; tt < 16; ++tt) { const float eb = __expf(bl[tt]); const float ib = __builtin_amdgcn_rcpf(eb);
        qs[tt] = qq[tt] * eb; kd[tt] = kk[tt] * ib; ke[tt] = kd[tt] * eT; qt[tt] = qs[tt] * eE; kh[tt] = ke[tt] * eA; }
    v4u a, b2;
    const int ro = k * (HP_PK * 2) + ic * 32;
    pack16<REV>(qs, a, b2); *(LAS v4u*)(L + HP_QS + ro) = a; *(LAS v4u*)(L + HP_QS + ro + 16) = b2;
    pack16<REV>(kd, a, b2); *(LAS v4u*)(L + HP_KD + ro) = a; *(LAS v4u*)(L + HP_KD + ro + 16) = b2;
    pack16<REV>(ke, a, b2); *(LAS v4u*)(L + HP_KE + ro) = a; *(LAS v4u*)(L + HP_KE + ro + 16) = b2;
    pack16<REV>(qt, a, b2); *(LAS v4u*)(L + HP_QT + ro) = a; *(LAS v4u*)(L + HP_QT + ro + 16) = b2;
    if (ic >= 2) { float t0[16];
#pragma unroll
        for (int tt = 0; tt < 16; ++tt) t0[tt] = qs[tt] * x0;
        pack16<REV>(t0, a, b2); const int xo = HP_QX + (ic == 2 ? 0 : 1) * (128 * HP_PX * 2) + k * (HP_PX * 2); *(LAS v4u*)(L + xo) = a; *(LAS v4u*)(L + xo + 16) = b2;
        if (ic == 3) {
#pragma unroll
            for (int tt = 0; tt < 16; ++tt) t0[tt] = qs[tt] * x1;
            pack16<REV>(t0, a, b2); const int xo2 = HP_QX + 2 * (128 * HP_PX * 2) + k * (HP_PX * 2); *(LAS v4u*)(L + xo2) = a; *(LAS v4u*)(L + xo2 + 16) = b2; } }
    pack16<REV>(kh, a, b2);
    { bf16* p = HK + ((((k >> 4) * 2 + (ic >> 1)) * 64) + 32 * (ic & 1) + (k & 15)) * 8; *(GAS v4u*)p = a; *(GAS v4u*)(p + 128) = b2; }
    { v4u c, d;
      if (!REV) { c.x = vv[0] | ((unsigned)vv[1] << 16); c.y = vv[2] | ((unsigned)vv[3] << 16); c.z = vv[4] | ((unsigned)vv[5] << 16); c.w = vv[6] | ((unsigned)vv[7] << 16);
                  d.x = vv[8] | ((unsigned)vv[9] << 16); d.y = vv[10] | ((unsigned)vv[11] << 16); d.z = vv[12] | ((unsigned)vv[13] << 16); d.w = vv[14] | ((unsigned)vv[15] << 16); }
      else { c.x = vv[15] | ((unsigned)vv[14] << 16); c.y = vv[13] | ((unsigned)vv[12] << 16); c.z = vv[11] | ((unsigned)vv[10] << 16); c.w = vv[9] | ((unsigned)vv[8] << 16);
             d.x = vv[7] | ((unsigned)vv[6] << 16); d.y = vv[5] | ((unsigned)vv[4] << 16); d.z = vv[3] | ((unsigned)vv[2] << 16); d.w = vv[1] | ((unsigned)vv[0] << 16); }
      bf16* p = HV + ((((k >> 4) * 2 + (ic >> 1)) * 64) + 32 * (ic & 1) + (k & 15)) * 8; *(GAS v4u*)p = c; *(GAS v4u*)(p + 128) = d; }
    if (i == 0) HDp[k] = __expf(T0 + T1 + T2 + T3);
    __syncthreads();
    const int lane = F.lane, qi = lane & 15, G = lane >> 4, w = F.wave;
#pragma unroll
    for (int f = 0; f < 2; ++f) { const int fw = (2 * w + f) >> 2, fs = (2 * w + f) & 3;
        const LAS unsigned char* p = L + HP_QT + (32 * fs + 4 * G + (qi >> 2)) * (HP_PK * 2) + (16 * fw + 4 * (qi & 3)) * 2;
        const v4s lo = na_tr16(p), hi = na_tr16(p + 16 * (HP_PK * 2));
        v4u o; o.x = (unsigned short)lo[0] | ((unsigned)(unsigned short)lo[1] << 16); o.y = (unsigned short)lo[2] | ((unsigned)(unsigned short)lo[3] << 16);
        o.z = (unsigned short)hi[0] | ((unsigned)(unsigned short)hi[1] << 16); o.w = (unsigned short)hi[2] | ((unsigned)(unsigned short)hi[3] << 16);
        *(GAS v4u*)(HQ + ((2 * w + f) * 64 + lane) * 8) = o; }
    for (int job = w; job < 16; job += NWAVES) {
        int ti, sj, qsel;
        switch (job) { case 0: ti = 0; sj = 0; qsel = 0; break; case 1: ti = 1; sj = 1; qsel = 0; break; case 2: ti = 2; sj = 2; qsel = 0; break; case 3: ti = 3; sj = 3; qsel = 0; break;
                       case 4: ti = 1; sj = 0; qsel = 0; break; case 5: ti = 2; sj = 1; qsel = 0; break; case 6: ti = 3; sj = 2; qsel = 0; break;
                       case 7: ti = 2; sj = 0; qsel = 1; break; case 8: ti = 3; sj = 1; qsel = 2; break; case 9: ti = 3; sj = 0; qsel = 3; break;
                       case 10: ti = 0; sj = 1; qsel = -1; break; case 11: ti = 0; sj = 2; qsel = -1; break; case 12: ti = 0; sj = 3; qsel = -1; break;
                       case 13: ti = 1; sj = 2; qsel = -1; break; case 14: ti = 1; sj = 3; qsel = -1; break; default: ti = 2; sj = 3; qsel = -1; break; }
        f32x4 acc = {0.f, 0.f, 0.f, 0.f};
        if (qsel >= 0) {
            const LAS unsigned char* ap = qsel == 0 ? L + HP_QS + (8 * G + (qi >> 2)) * (HP_PK * 2) + (16 * ti + 4 * (qi & 3)) * 2
                                                    : L + HP_QX + (qsel - 1) * (128 * HP_PX * 2) + (8 * G + (qi >> 2)) * (HP_PX * 2) + (4 * (qi & 3)) * 2;
            const int apitch = qsel == 0 ? HP_PK * 2 : HP_PX * 2;
            const LAS unsigned char* bp = L + (ti == sj ? HP_KD : HP_KE) + (8 * G + (qi >> 2)) * (HP_PK * 2) + (16 * sj + 4 * (qi & 3)) * 2;
#pragma unroll
            for (int ks = 0; ks < 4; ++ks) {
                const v4s a0 = na_tr16(ap + (32 * ks) * apitch), a1 = na_tr16(ap + (32 * ks + 4) * apitch);
                const v4s b0 = na_tr16(bp + (32 * ks) * (HP_PK * 2)), b1 = na_tr16(bp + (32 * ks + 4) * (HP_PK * 2));
                const bf16x8 af = {a0[0], a0[1], a0[2], a0[3], a1[0], a1[1], a1[2], a1[3]}, bf = {b0[0], b0[1], b0[2], b0[3], b1[0], b1[1], b1[2], b1[3]};
                acc = mfma16(af, bf, acc); }
        }
        LAS bf16* im = (LAS bf16*)(L + HP_HA);
#pragma unroll
        for (int r = 0; r < 4; ++r) { float v = acc[r]; if (ti == sj && qi > 4 * G + r) v = 0.f;
            im[(16 * ti + 4 * G + r) * HP_PK + 16 * sj + qi] = (unsigned short)(cvtpk(v, v) & 0xffffu); }
    }
    __syncthreads();
    { const v4u o = *(const LAS v4u*)(L + HP_HA + (16 * (w >> 1) + qi) * (HP_PK * 2) + (32 * (w & 1) + 8 * G) * 2); *(GAS v4u*)(HA + (w * 64 + lane) * 8) = o; }
    __syncthreads();
}
__device__ __forceinline__ void hprep_unit(Frame& F, bool meta, int b, int h, int j, unsigned char* r2, size_t u0, unsigned char* mb0) {
    const bf16* P = (const bf16*)(F.ws + WS_R1); const bf16* PM = (const bf16*)(F.ws + WS_PROJM);
    const int k = F.tid & 127, i = F.tid >> 7;
    const float* lbl = F.in[6] + h * 128 + k;
    const float lbf = sigmoidf_(lbl[0] - lbl[512]), lbb = sigmoidf_(lbl[1024] - lbl[1536]);
    float gf[16], kf[16], gb[16], kb[16], qq[16]; unsigned short vv[16];
    const bool ok = !meta || i == 0;
    unsigned short rxf[16], rxb[16], rqv[16];
#pragma unroll
    for (int tt = 0; tt < 16; ++tt) {
        const bf16* rp = meta ? PM + (size_t)tt * INC : P + (size_t)(b * SEQ + 64 * j + 16 * i + tt) * INC;
        rxf[tt] = rp[C_FF + h * 128 + k]; rxb[tt] = rp[C_FB + h * 128 + k]; rqv[tt] = rp[C_QH + h * 128 + k]; vv[tt] = rp[C_IH + h * 128 + k];
    }
    __builtin_amdgcn_sched_barrier(0);
#pragma unroll
    for (int tt = 0; tt < 16; ++tt) {
        const float xf = fmaxf(bf2f(rxf[tt]), -80.f), xb = fmaxf(bf2f(rxb[tt]), -80.f), qv = fmaxf(bf2f(rqv[tt]), -80.f);
        const float ef = __expf(-xf), sf = __builtin_amdgcn_rcpf(1.0f + ef), eb = __expf(-xb), sb = __builtin_amdgcn_rcpf(1.0f + eb), eq = __expf(-qv), sq = __builtin_amdgcn_rcpf(1.0f + eq);
        gf[tt] = ok ? __logf(lbf + (1.0f - lbf) * sf) : 0.f; kf[tt] = ok ? (1.0f - lbf) * ef * sf : 0.f;
        gb[tt] = ok ? __logf(lbb + (1.0f - lbb) * sb) : 0.f; kb[tt] = ok ? (1.0f - lbb) * eb * sb : 0.f;
        qq[tt] = ok ? qv * sq : 0.f; vv[tt] = ok ? vv[tt] : (unsigned short)0;
    }
    if (!meta) {
        hprep_dir<false>(F, gf, kf, qq, vv, 0, (bf16*)(r2 + R2_HQ) + u0 * HU_Q, (bf16*)(r2 + R2_HK) + u0 * HU_K, (bf16*)(r2 + R2_HV) + u0 * HU_V, (bf16*)(r2 + R2_HA) + u0 * HU_A, (float*)(r2 + R2_HD) + u0 * HU_D);
        hprep_dir<true>(F, gb, kb, qq, vv, 1, (bf16*)(r2 + R2_HQ) + (u0 + 1) * HU_Q, (bf16*)(r2 + R2_HK) + (u0 + 1) * HU_K, (bf16*)(r2 + R2_HV) + (u0 + 1) * HU_V, (bf16*)(r2 + R2_HA) + (u0 + 1) * HU_A, (float*)(r2 + R2_HD) + (u0 + 1) * HU_D);
    } else {
        hprep_dir<false>(F, gf, kf, qq, vv, 0, (bf16*)(mb0 + 49152), (bf16*)(mb0), (bf16*)(mb0 + 16384), (bf16*)(mb0 + 32768), (float*)(mb0 + 40960));
        hprep_dir<false>(F, gb, kb, qq, vv, 1, (bf16*)(mb0 + 65536 + 49152), (bf16*)(mb0 + 65536), (bf16*)(mb0 + 65536 + 16384), (bf16*)(mb0 + 65536 + 32768), (float*)(mb0 + 65536 + 40960));
    }
}
__device__ __forceinline__ void p2_hprep(Frame& F) {
    unsigned char* r2 = F.ws + WS_R2;
    for (int u = F.vcu; u < 1024 + 4; u += F.G) {
        if (u < 1024) { const int j = u & 63, h = (u >> 6) & 3, b = u >> 8; hprep_unit(F, false, b, h, j, r2, (size_t)u * 2, nullptr); }
        else { const int h = u - 1024; hprep_unit(F, true, 0, h, 0, r2, 0, r2 + R2_META + (size_t)(h * 2) * 65536); }
    }
}

#ifndef HS_WARM
#define HS_WARM 0
#endif
struct HSOps { bf16x8 qf[4], af[2], kf[2][2]; };
constexpr int HS_SBUF = 0, HS_OBUF = 16384, HS_DUMMY = 32768, HS_RING = 36864, HS_STAGE = 5120;
__device__ __forceinline__ void ld16(bf16x8& r, const void* p) { asm volatile("global_load_dwordx4 %0, %1, off" : "=v"(r) : "v"(p) : "memory"); }
struct HSPtr { const unsigned char *HQ, *HK, *HV, *HA, *HD; };
__device__ __forceinline__ HSPtr hseq_ptrs(unsigned char* r2, int c, int b, int h, int dir) {
    c = c > 64 ? 64 : (c < 0 ? 0 : c);
    HSPtr p;
    if (c == 0) { const int mu = h * 2 + dir; const unsigned char* mb = r2 + R2_META + (size_t)mu * 65536; p.HK = mb; p.HV = mb + 16384; p.HA = mb + 32768; p.HD = mb + 40960; p.HQ = mb + 49152; }
    else { const int j = dir ? 64 - c : c - 1; const size_t u = (size_t)(((b * 4 + h) * 64 + j) * 2 + dir);
        p.HQ = r2 + R2_HQ + u * HU_Q * 2; p.HK = r2 + R2_HK + u * HU_K * 2; p.HV = r2 + R2_HV + u * HU_V * 2; p.HA = r2 + R2_HA + u * HU_A * 2; p.HD = r2 + R2_HD + u * HU_D * 4; }
    return p;
}
__device__ __forceinline__ void hseq_load(HSOps& L, unsigned char* r2, int c, int b, int h, int dir, int w, int lane) {
    const HSPtr p = hseq_ptrs(r2, c, b, h, dir);
#pragma unroll
    for (int s = 0; s < 4; ++s) ld16(L.qf[s], p.HQ + ((w * 4 + s) * 64 + lane) * 16);
#pragma unroll
    for (int ks = 0; ks < 2; ++ks) { ld16(L.af[ks], p.HA + ((w * 2 + ks) * 64 + lane) * 16);
#pragma unroll
        for (int i = 0; i < 2; ++i) ld16(L.kf[i][ks], p.HK + (((w * 2 + i) * 2 + ks) * 64 + lane) * 16); }
}
#define HSEQ_WAIT(L) asm volatile("s_waitcnt vmcnt(30)" : "+v"(L.qf[0]), "+v"(L.qf[1]), "+v"(L.qf[2]), "+v"(L.qf[3]), "+v"(L.af[0]), "+v"(L.af[1]), "+v"(L.kf[0][0]), "+v"(L.kf[0][1]), "+v"(L.kf[1][0]), "+v"(L.kf[1][1]) :: "memory")
#define HSEQ_BAR() do { asm volatile("s_waitcnt lgkmcnt(0)" ::: "memory"); __builtin_amdgcn_s_barrier(); asm volatile("" ::: "memory"); } while (0)
__device__ __forceinline__ void hseq_step(HSOps& L, f32x4 (&st)[2][2], LAS unsigned char* lds, int c, int w, int lane, int qi, int G) {
    LAS v4u* sbuf = (LAS v4u*)(lds + HS_SBUF); LAS float* obuf = (LAS float*)(lds + HS_OBUF);
#pragma unroll
    for (int nt = 0; nt < 2; ++nt) { v4u sw; sw.x = pk2(st[0][nt][0], st[0][nt][1]); sw.y = pk2(st[0][nt][2], st[0][nt][3]); sw.z = pk2(st[1][nt][0], st[1][nt][1]); sw.w = pk2(st[1][nt][2], st[1][nt][3]);
        sbuf[(((c & 1) * 4 + w) * 2 + nt) * 64 + lane] = sw; }
    HSEQ_BAR();
    HSEQ_WAIT(L);
    const LAS unsigned char* rg = lds + HS_RING + (c & 3) * HS_STAGE;
    bf16x8 vf[2][2]; f32x4 dv[2];
#pragma unroll
    for (int nt = 0; nt < 2; ++nt)
#pragma unroll
        for (int ks = 0; ks < 2; ++ks) vf[nt][ks] = *(const LAS bf16x8*)(rg + ((nt * 2 + ks) * 64 + lane) * 16);
#pragma unroll
    for (int i = 0; i < 2; ++i) dv[i] = *(const LAS f32x4*)(rg + 4096 + (32 * w + 16 * i + 4 * G) * 4);
    f32x4 o[2] = {{0.f, 0.f, 0.f, 0.f}, {0.f, 0.f, 0.f, 0.f}};
#pragma unroll
    for (int s = 0; s < 4; ++s)
#pragma unroll
        for (int nt = 0; nt < 2; ++nt) { const v4u sb = sbuf[(((c & 1) * 4 + s) * 2 + nt) * 64 + lane]; o[nt] = mfma16(L.qf[s], __builtin_bit_cast(bf16x8, sb), o[nt]); }
#pragma unroll
    for (int ks = 0; ks < 2; ++ks)
#pragma unroll
        for (int nt = 0; nt < 2; ++nt) o[nt] = mfma16(L.af[ks], vf[nt][ks], o[nt]);
#pragma unroll
    for (int i = 0; i < 2; ++i)
#pragma unroll
        for (int nt = 0; nt < 2; ++nt) { st[i][nt] = st[i][nt] * dv[i];
#pragma unroll
            for (int ks = 0; ks < 2; ++ks) st[i][nt] = mfma16(L.kf[i][ks], vf[nt][ks], st[i][nt]); }
    LAS float* ob = obuf + ((c & 1) * 4 + w) * 512;
#pragma unroll
    for (int nt = 0; nt < 2; ++nt)
#pragma unroll
        for (int r = 0; r < 4; ++r) ob[(4 * G + r) * 32 + 16 * nt + qi] = o[nt][r];
}
__device__ __forceinline__ void hseq_helper(unsigned char* r2, bf16* Od, float* dummy, LAS unsigned char* lds, int c, int PD, int b, int h, int dir, int vp, int hw, int lane) {
    { const HSPtr p = hseq_ptrs(r2, c + 3, b, h, dir); LAS unsigned char* rg = lds + HS_RING + ((c + 3) & 3) * HS_STAGE;
      __builtin_amdgcn_global_load_lds((const unsigned*)(p.HV + (size_t)vp * 4096 + hw * 1024 + lane * 16), (LAS unsigned*)(rg + hw * 1024), 16, 0, 0);
      if (hw == 0) __builtin_amdgcn_global_load_lds((const unsigned*)(p.HD + lane * 16), (LAS unsigned*)(rg + 4096), 16, 0, 0); }
    { const int cs = c - 1; const bool real = cs >= 1 && cs <= 64; const int j = dir ? 64 - cs : cs - 1;
      const LAS float* ob = (const LAS float*)(lds + HS_OBUF) + ((cs & 1) * 4 + hw) * 512;
#pragma unroll
      for (int i = 0; i < 2; ++i) { const int row = 8 * i + (lane >> 3), tc = 16 * hw + row, tk = dir ? 63 - tc : tc;
          const f32x4 v = *(const LAS f32x4*)(ob + row * 32 + 4 * (lane & 7));
          bf16* dst = real ? Od + (size_t)(b * SEQ + 64 * j + tk) * 512 + h * 128 + 32 * vp + 4 * (lane & 7) : (bf16*)dummy + (i * 64 + lane) * 4;
          v2u pk; pk.x = cvtpk(v.x, v.y); pk.y = cvtpk(v.z, v.w); *(GAS v2u*)dst = pk; } }
#if HS_WARM
    { const HSPtr p = hseq_ptrs(r2, c + PD, b, h, dir); LAS unsigned* slot = (LAS unsigned*)(lds + HS_DUMMY + hw * 1024);
#pragma unroll
      for (int i = 0; i < 3; ++i) { const int q = 10 * vp + hw + 4 * i;
          if (i < 2 || hw < 2) { const unsigned char* s = q < 16 ? p.HQ + q * 1024 : (q < 32 ? p.HK + (q - 16) * 1024 : p.HA + (q - 32) * 1024);
              __builtin_amdgcn_global_load_lds((const unsigned*)(s + lane * 16), slot, 16, 0, 0); } } }
#endif
}
__device__ __forceinline__ void p3_hseq(Frame& F) {
    const int blk = blockIdx.x;
    if (blk < 128) {
    const int x = blk & 7, q = blk >> 3, chain = (x * 4 + (q >> 2)) & 31, vp = q & 3;
    const int dir = chain & 1, h = (chain >> 1) & 3, b = chain >> 3;
    unsigned char* r2 = F.ws + WS_R2;
    bf16* Od = (bf16*)(r2 + (dir ? R2_OB : R2_OF));
    LAS unsigned char* lds = F.lds + RING_OFF;
    const int lane = F.lane, qi = lane & 15, G = lane >> 4, w = F.wave;
    constexpr int PD = 6;
    if (w < 4) {
        f32x4 st[2][2] = {{{0.f, 0.f, 0.f, 0.f}, {0.f, 0.f, 0.f, 0.f}}, {{0.f, 0.f, 0.f, 0.f}, {0.f, 0.f, 0.f, 0.f}}};
        HSOps A, B, C, Dq;
        asm volatile("s_waitcnt vmcnt(0)" ::: "memory");
        hseq_load(A, r2, 0, b, h, dir, w, lane); hseq_load(B, r2, 1, b, h, dir, w, lane); hseq_load(C, r2, 2, b, h, dir, w, lane);
        HSEQ_BAR();
#pragma unroll 1
        for (int c = 0; c < 68; c += 4) {
            hseq_load(Dq, r2, c + 3, b, h, dir, w, lane);
            hseq_step(A, st, lds, c, w, lane, qi, G);
            if (c + 1 > 64) { HSEQ_BAR(); break; }
            hseq_load(A, r2, c + 4, b, h, dir, w, lane);
            hseq_step(B, st, lds, c + 1, w, lane, qi, G);
            hseq_load(B, r2, c + 5, b, h, dir, w, lane);
            hseq_step(C, st, lds, c + 2, w, lane, qi, G);
            hseq_load(C, r2, c + 6, b, h, dir, w, lane);
            hseq_step(Dq, st, lds, c + 3, w, lane, qi, G);
        }
        asm volatile("s_waitcnt vmcnt(0)" ::: "memory");
    } else {
        const int hw = w - 4;
        float* dummy = (float*)(r2 + R2_META + 2 * MiB) + ((size_t)blk * 4 + hw) * 512;
        asm volatile("s_waitcnt vmcnt(0)" ::: "memory");
#pragma unroll 1
        for (int c = -3; c < 0; ++c) hseq_helper(r2, Od, dummy, lds, c, PD, b, h, dir, vp, hw, lane);
        asm volatile("s_waitcnt vmcnt(0)" ::: "memory");
        HSEQ_BAR();
#pragma unroll 1
        for (int c = 0; c <= 65; ++c) {
            HSEQ_BAR();
            hseq_helper(r2, Od, dummy, lds, c, PD, b, h, dir, vp, hw, lane);
#if HS_WARM
            if (hw == 0) asm volatile("s_waitcnt vmcnt(14)" ::: "memory"); else if (hw == 1) asm volatile("s_waitcnt vmcnt(12)" ::: "memory"); else asm volatile("s_waitcnt vmcnt(10)" ::: "memory");
#else
            if (hw == 0) asm volatile("s_waitcnt vmcnt(8)" ::: "memory"); else asm volatile("s_waitcnt vmcnt(6)" ::: "memory");
#endif
        }
        asm volatile("s_waitcnt vmcnt(0)" ::: "memory");
    }
    }
    __syncthreads();
}

__device__ __forceinline__ void p4_combine(Frame& F) {
    const int gw = F.vcu * NWAVES + F.wave, NGW = F.G * NWAVES, lane = F.lane;
    const bf16* OF = (const bf16*)(F.ws + WS_R2 + R2_OF); const bf16* OB = (const bf16*)(F.ws + WS_R2 + R2_OB);
    const bf16* P = (const bf16*)(F.ws + WS_R1); bf16* Y = (bf16*)(F.ws + WS_Y); const float* gn = F.in[7];
    const f32x4 g0 = *(const GAS f32x4*)(gn + 8 * lane), g1 = *(const GAS f32x4*)(gn + 8 * lane + 4);
    for (int m = gw; m < M; m += NGW) {
        const int c0 = 8 * lane;
        const v4u af = *(const GAS v4u*)(OF + (size_t)m * 512 + c0), ab = *(const GAS v4u*)(OB + (size_t)m * 512 + c0);
        const v4u gt = *(const GAS v4u*)(P + (size_t)m * INC + C_GH + c0);
        const f32x4 o0 = {bflo(af.x) + bflo(ab.x), bfhi(af.x) + bfhi(ab.x), bflo(af.y) + bflo(ab.y), bfhi(af.y) + bfhi(ab.y)};
        const f32x4 o1 = {bflo(af.z) + bflo(ab.z), bfhi(af.z) + bfhi(ab.z), bflo(af.w) + bflo(ab.w), bfhi(af.w) + bfhi(ab.w)};
        float q = (o0.x * o0.x + o0.y * o0.y) + (o0.z * o0.z + o0.w * o0.w) + (o1.x * o1.x + o1.y * o1.y) + (o1.z * o1.z + o1.w * o1.w);
        q += __shfl_xor(q, 1); q += __shfl_xor(q, 2); q += __shfl_xor(q, 4); q += __shfl_xor(q, 8);
        const float rstd = __builtin_amdgcn_rsqf(q * (1.0f / 128.0f) + RMS_EPS);
        float gv[8] = {bflo(gt.x), bfhi(gt.x), bflo(gt.y), bfhi(gt.y), bflo(gt.z), bfhi(gt.z), bflo(gt.w), bfhi(gt.w)};
        float ov[8] = {o0.x * g0.x, o0.y * g0.y, o0.z * g0.z, o0.w * g0.w, o1.x * g1.x, o1.y * g1.y, o1.z * g1.z, o1.w * g1.w};
#pragma unroll
        for (int i = 0; i < 8; ++i) ov[i] = ov[i] * rstd * (gv[i] * sigmoidf_(gv[i]));
        v4u wv; wv.x = pk2(ov[0], ov[1]); wv.y = pk2(ov[2], ov[3]); wv.z = pk2(ov[4], ov[5]); wv.w = pk2(ov[6], ov[7]);
        *(GAS v4u*)(Y + (size_t)m * D + 512 + c0) = wv;
    }
}

__device__ __forceinline__ void p6_router(Frame& F, bool dry) {
    LAS float* lgs = (LAS float*)(F.lds + RING_OFF);
    LAS float* partL = lgs + 64 * 33;
    LAS float* rsL = partL + 8 * 64 * 36;
    LAS int* cntL = (LAS int*)(F.lds + TILE_E_OFF);
    LAS int* baseL = cntL + 32; LAS int* selE = cntL + 64; LAS int* selP = selE + 256; LAS float* selW = (LAS float*)(selP + 256);
    static_assert(TILE_E_OFF + (64 + 768) * 4 <= LDS_BYTES, "router LDS");
    static_assert((64 * 33 + 8 * 64 * 36 + 64) * 4 <= RING_BYTES, "router LDS (logits)");
    if (F.tid < 32) cntL[F.tid] = 0;
    __syncthreads();
    const float* HM = (const float*)(F.ws + WS_HMID); unsigned char* XN2 = F.ws + WS_XN2;
    const float* g2 = F.in[9]; const float* rb = F.in[11]; const bf16* WrT = (const bf16*)(F.ws + WS_WRT);
    const int lane = F.lane, qi = lane & 15, G = lane >> 4, w = F.wave;
    const float rbias = rb[F.tid & 31];
    for (int rb0 = F.vcu * 64; rb0 < M; rb0 += F.G * 64) {
        const float* xr = HM + (size_t)(rb0 + qi) * D + 128 * w + 8 * G;
        f32x4 acc[4][2];
#pragma unroll
        for (int mt = 0; mt < 4; ++mt) { acc[mt][0] = (f32x4){0.f, 0.f, 0.f, 0.f}; acc[mt][1] = (f32x4){0.f, 0.f, 0.f, 0.f}; }
        const bf16* wh0 = WrT + (size_t)qi * D + 128 * w + 8 * G; const bf16* wl0 = wh0 + NE * D;
        const float* gk = g2 + 128 * w + 8 * G;
        unsigned char* xo = XN2 + (size_t)(rb0 + qi) * D + 128 * w + 8 * G;
        float rs4[4] = {0.f, 0.f, 0.f, 0.f};
#pragma unroll 1
        for (int tr = 0; tr < 2; ++tr) {
            f32x4 xa4[4][2], xb4[4][2], ga4[2], gb4[2]; bf16x8 bh4[2][2], bl4[2][2];
#pragma unroll
            for (int u = 0; u < 2; ++u) { const int ks = 2 * tr + u;
#pragma unroll
                for (int mt = 0; mt < 4; ++mt) { xa4[mt][u] = *(const GAS f32x4*)(xr + (size_t)(16 * mt) * D + 32 * ks); xb4[mt][u] = *(const GAS f32x4*)(xr + (size_t)(16 * mt) * D + 32 * ks + 4); }
                ga4[u] = *(const GAS f32x4*)(gk + 32 * ks); gb4[u] = *(const GAS f32x4*)(gk + 32 * ks + 4);
#pragma unroll
                for (int nt = 0; nt < 2; ++nt) { bh4[u][nt] = *(const GAS bf16x8*)(wh0 + (size_t)nt * 16 * D + 32 * ks); bl4[u][nt] = *(const GAS bf16x8*)(wl0 + (size_t)nt * 16 * D + 32 * ks); } }
            __builtin_amdgcn_sched_barrier(0);
            if (tr == 0) {
                if (F.tid < 64) { const GAS f32x4* rp = (const GAS f32x4*)((const float*)(F.ws + WS_ROWSS) + (size_t)(rb0 + F.tid) * 16);
                    const f32x4 p0 = rp[0], p1 = rp[1], p2 = rp[2], p3 = rp[3];
                    const float ss = (((p0.x + p0.y) + (p0.z + p0.w)) + ((p1.x + p1.y) + (p1.z + p1.w))) + (((p2.x + p2.y) + (p2.z + p2.w)) + ((p3.x + p3.y) + (p3.z + p3.w)));
                    rsL[F.tid] = __builtin_amdgcn_rsqf(ss * (1.f / D) + RMS_EPS); }
                __syncthreads();
#pragma unroll
                for (int mt = 0; mt < 4; ++mt) rs4[mt] = rsL[16 * mt + qi];
            }
#pragma unroll
            for (int u = 0; u < 2; ++u) { const int ks = 2 * tr + u;
#pragma unroll
                for (int mt = 0; mt < 4; ++mt) {
                    const f32x4 xa = xa4[mt][u] * rs4[mt] * ga4[u], xb = xb4[mt][u] * rs4[mt] * gb4[u];
                    v4u hi, lo;
                    hi.x = cvtpk(xa.x, xa.y); hi.y = cvtpk(xa.z, xa.w); hi.z = cvtpk(xb.x, xb.y); hi.w = cvtpk(xb.z, xb.w);
                    lo.x = cvtpk(xa.x - bflo(hi.x), xa.y - bfhi(hi.x)); lo.y = cvtpk(xa.z - bflo(hi.y), xa.w - bfhi(hi.y)); lo.z = cvtpk(xb.x - bflo(hi.z), xb.y - bfhi(hi.z)); lo.w = cvtpk(xb.z - bflo(hi.w), xb.w - bfhi(hi.w));
                    const bf16x8 ah = __builtin_bit_cast(bf16x8, hi), al = __builtin_bit_cast(bf16x8, lo);
                    acc[mt][0] = mfma16(ah, bh4[u][0], acc[mt][0]); acc[mt][0] = mfma16(ah, bl4[u][0], acc[mt][0]); acc[mt][0] = mfma16(al, bh4[u][0], acc[mt][0]);
                    acc[mt][1] = mfma16(ah, bh4[u][1], acc[mt][1]); acc[mt][1] = mfma16(ah, bl4[u][1], acc[mt][1]); acc[mt][1] = mfma16(al, bh4[u][1], acc[mt][1]);
                    v2u o; o.x = pg8::pk4_fp8(xa.x, xa.y, xa.z, xa.w); o.y = pg8::pk4_fp8(xb.x, xb.y, xb.z, xb.w);
                    *(GAS v2u*)(xo + (size_t)(16 * mt) * D + 32 * ks) = o; } }
        }
        { LAS float* pw = partL + w * (64 * 36);
#pragma unroll
          for (int mt = 0; mt < 4; ++mt)
#pragma unroll
              for (int r = 0; r < 4; ++r) { pw[(16 * mt + 4 * G + r) * 36 + qi] = acc[mt][0][r]; pw[(16 * mt + 4 * G + r) * 36 + 16 + qi] = acc[mt][1][r]; } }
        __syncthreads();
#pragma unroll
        for (int i = 0; i < 4; ++i) { const int idx = F.tid + 512 * i, row = idx >> 5, e = idx & 31; float sm = rbias;
#pragma unroll
            for (int ww = 0; ww < 8; ++ww) sm += partL[ww * (64 * 36) + row * 36 + e];
            lgs[row * 33 + e] = sm; }
        __syncthreads();
        if (F.tid < 64) {
            float lg[32];
#pragma unroll
            for (int e = 0; e < 32; ++e) lg[e] = lgs[F.tid * 33 + e];
            int ti[4]; float tv[4];
#pragma unroll
            for (int t = 0; t < 4; ++t) { float best = -3.0e38f; int bi = 0;
#pragma unroll
                for (int e = 0; e < 32; ++e) { const bool tk = (t > 0 && ti[0] == e) || (t > 1 && ti[1] == e) || (t > 2 && ti[2] == e); if (!tk && lg[e] > best) { best = lg[e]; bi = e; } }
                ti[t] = bi; tv[t] = best; }
            const float p1 = __expf(tv[1] - tv[0]), p2 = __expf(tv[2] - tv[0]), p3 = __expf(tv[3] - tv[0]); const float inv = 1.0f / (1.0f + p1 + p2 + p3);
            const float wsm[4] = {inv, p1 * inv, p2 * inv, p3 * inv};
#pragma unroll
            for (int t = 0; t < 4; ++t) { const int lp = __hip_atomic_fetch_add(cntL + ti[t], 1, __ATOMIC_RELAXED, __HIP_MEMORY_SCOPE_WORKGROUP);
                selE[F.tid * 4 + t] = ti[t]; selP[F.tid * 4 + t] = lp; selW[F.tid * 4 + t] = wsm[t]; }
        }
        __syncthreads();
        if (F.tid < 32 && !dry) { const int n = cntL[F.tid]; baseL[F.tid] = n > 0 ? (int)__hip_atomic_fetch_add(F.ctl + CW_CNT + F.tid, (unsigned)n, RLX_AGENT) : 0; }
        __syncthreads();
        if (F.tid < 256 && !dry) { const int e = selE[F.tid], pos = baseL[e] + selP[F.tid]; const int tok4 = (rb0 + (F.tid >> 2)) * 4 + (F.tid & 3);
            ((unsigned*)(F.ws + WS_LIST))[(size_t)e * LCAP + pos] = (unsigned)tok4 | (pk2(selW[F.tid], selW[F.tid]) & 0xffff0000u); }
        __syncthreads();
        if (F.tid < 32) cntL[F.tid] = 0;
        __syncthreads();
    }
}

__device__ __forceinline__ int moe_table(Frame& F) {
    LAS int* tileE = (LAS int*)(F.lds + TILE_E_OFF); LAS int* rowbase = tileE + NTILE_MAX; LAS int* cntS = rowbase + 32; LAS int* ntS = cntS + 32;
    if (F.tid == 0) { int nt = 0;
        for (int e = 0; e < NE; ++e) { const int c = (int)__hip_atomic_load(F.ctl + CW_CNT + e, RLX_AGENT); cntS[e] = c; rowbase[e] = nt * 256; const int t = (c + 255) >> 8; for (int i = 0; i < t; ++i) tileE[nt + i] = e; nt += t; }
        ntS[0] = nt; }
    __syncthreads();
    return ntS[0];
}

__device__ __forceinline__ void p9_final(Frame& F) {
    typedef float f32x2_t __attribute__((ext_vector_type(2)));
    const int gw = F.vcu * NWAVES + F.wave, NGW = F.G * NWAVES, lane = F.lane;
    const float* HM = (const float*)(F.ws + WS_HMID); const unsigned char* YS = F.ws + WS_R1; const float* gf = F.in[16];
    f32x4 gfv[4];
#pragma unroll
    for (int j = 0; j < 4; ++j) gfv[j] = *(const GAS f32x4*)(gf + 4 * lane + 256 * j);
    for (int m = gw; m < M; m += NGW) {
        f32x4 v[4]; float s = 0.f;
#pragma unroll
        for (int j = 0; j < 4; ++j) { f32x4 ya = {0.f, 0.f, 0.f, 0.f};
#pragma unroll
            for (int k = 0; k < 4; ++k) { const int y = *(const GAS int*)(YS + ((size_t)m * 4 + k) * D + 4 * lane + 256 * j);
                const f32x2_t lo = __builtin_amdgcn_cvt_pk_f32_fp8(y, false), hi = __builtin_amdgcn_cvt_pk_f32_fp8(y, true);
                ya.x += lo.x; ya.y += lo.y; ya.z += hi.x; ya.w += hi.y; }
            v[j] = *(const GAS f32x4*)(HM + (size_t)m * D + 4 * lane + 256 * j) + ya * (1.0f / 8.0f);
            s += (v[j].x * v[j].x + v[j].y * v[j].y) + (v[j].z * v[j].z + v[j].w * v[j].w); }
        const float rstd = __builtin_amdgcn_rsqf(wave_sum(s) * (1.f / D) + RMS_EPS);
#pragma unroll
        for (int j = 0; j < 4; ++j) *(GAS f32x4*)(F.out + (size_t)m * D + 4 * lane + 256 * j) = v[j] * rstd * gfv[j];
    }
}

#ifndef PROBE_DUP
#define PROBE_DUP -1
#endif
struct Args { const float* in[17]; float* out; unsigned char* ws; int ph_lo, ph_hi, li, pad; };
__global__ void __launch_bounds__(NWAVES * 64, 2) hymba_fwd(Args args) {
    extern __shared__ __attribute__((aligned(16))) unsigned char lds[];
    Frame F;
    F.lds = (LAS unsigned char*)lds;
    F.MISC = (volatile LAS unsigned*)(F.lds + MISC_OFF);
    F.tid = threadIdx.x; F.lane = F.tid & 63; F.wave = __builtin_amdgcn_readfirstlane(F.tid >> 6);
    F.G = gridDim.x; { const int bx = blockIdx.x; F.vcu = (F.G % 8 == 0) ? (bx % 8) * (F.G / 8) + bx / 8 : bx; }
    F.ws = args.ws; F.ctl = (gu32*)(args.ws + WS_CTL); F.out = args.out;
#pragma unroll
    for (int i = 0; i < 17; ++i) F.in[i] = args.in[i];
    for (int u = F.tid; u < (LDS_BYTES - LDSCTL_OFF) / 4; u += NWAVES * 64) ((LAS unsigned*)(F.lds + LDSCTL_OFF))[u] = 0u;
    __syncthreads();
    XcdBarrier bar; bar.bar = (unsigned*)(F.ctl + CW_BAR); bar.x = 0; bar.st = nullptr;
    if (N_LAUNCHES == 1) bar = xcd_barrier_post((unsigned*)(F.ctl + CW_BAR), F.MISC + 8);
#define GRID_BAR() do { if (N_LAUNCHES == 1) { xcd_barrier(bar); if (PROBE_DUP == 99) xcd_barrier(bar); } } while (0)
    const int lo = args.ph_lo, hi = args.ph_hi;
#define IN(k) (lo <= (k) && (k) < hi)
#define BOTH(k) (IN(k) && IN((k) + 1))

#define REPS(k) ((PROBE_DUP == (k)) ? 2 : 1)
#define REPEAT(k, body) do { for (int rep_ = 0; rep_ < REPS(k); ++rep_) { body; if (rep_ + 1 < REPS(k)) GRID_BAR(); } } while (0)
    if (IN(0)) { REPEAT(0, p0_prologue(F)); if (BOTH(0)) GRID_BAR(); }
    if (IN(1)) {
        REPEAT(100, p1_meta_proj(F));
        for (int rep_ = 0; rep_ < REPS(1); ++rep_) {
        pg8::Gemm g{(const bf16*)(F.ws + WS_XN), (const bf16*)(F.ws + WS_WIN), M, INC, D}; pg8::StaticOrder S; S.init(M, INC, F.G, (int)blockIdx.x);
        pg8::EpiProj E{(bf16*)(F.ws + WS_R1)};
        pg8::gemm_phase<pg8::EpiProj, pg8::StaticOrder, true, true>(F.lds + RING_OFF, g, S, E);
        if (rep_ + 1 < REPS(1)) GRID_BAR(); }
        if (BOTH(1)) GRID_BAR();
    }
    if (IN(2)) { REPEAT(20, p2_natten(F)); REPEAT(21, p2_hprep(F)); if (BOTH(2)) GRID_BAR(); }
    if (IN(3)) { p3_hseq(F); if (PROBE_DUP == 3) { GRID_BAR(); p3_hseq(F); } p3_convert<false>(F, 0, 0); if (BOTH(3)) GRID_BAR(); }
    if (IN(4)) { REPEAT(4, p4_combine(F)); if (BOTH(4)) GRID_BAR(); }
    if (IN(5)) {
        { pg8::Gemm g{(const bf16*)(F.ws + WS_Y), (const bf16*)(F.ws + WS_WOUT), M, D, D}; pg8::StaticOrder S; S.init(M, D, F.G, (int)blockIdx.x);
          pg8::EpiResF32 E{F.in[0], (float*)(F.ws + WS_HMID), (float*)(F.ws + WS_ROWSS)};
          pg8::gemm_phase<pg8::EpiResF32, pg8::StaticOrder, false, true>(F.lds + RING_OFF, g, S, E); }
        if (PROBE_DUP == 5) { GRID_BAR();
          pg8::Gemm g{(const bf16*)(F.ws + WS_Y), (const bf16*)(F.ws + WS_WOUT), M, D, D}; pg8::StaticOrder S; S.init(M, D, F.G, (int)blockIdx.x);
          pg8::EpiResF32 E{F.in[0], (float*)(F.ws + WS_HMID), (float*)(F.ws + WS_ROWSS)};
          pg8::gemm_phase<pg8::EpiResF32, pg8::StaticOrder, false, true>(F.lds + RING_OFF, g, S, E); }
        if (BOTH(5)) GRID_BAR();
    }
    if (IN(6)) { p6_router(F, false); if (PROBE_DUP == 6) { GRID_BAR(); p6_router(F, true); } if (BOTH(6)) GRID_BAR(); }
    if (IN(8)) {
        const int NT = moe_table(F);
        for (int rep_ = 0; rep_ < REPS(8); ++rep_) {
        pg8::Gemm g{(const bf16*)(F.ws + WS_XN2), (const bf16*)(F.ws + WS_WGU), NT * 256, 2048, D}; pg8::MoeOrder S; S.init(NT, 8, F.G, (int)blockIdx.x, 2048, (const LAS int*)(F.lds + TILE_E_OFF), (const int*)(F.ws + WS_LIST), LCAP);
        pg8::EpiSwigluF8 E{F.ws + WS_R2, F.in[13]};
        pg8::gemm_phase<pg8::EpiSwigluF8, pg8::MoeOrder, true, true, true, true>(F.lds + RING_OFF, g, S, E);
        if (rep_ + 1 < REPS(8)) GRID_BAR(); }
        p3_convert<true>(F, 32, 1);
        if (BOTH(8)) GRID_BAR();
    }
    if (IN(9)) {
        const int NT = moe_table(F);
        for (int rep_ = 0; rep_ < REPS(9); ++rep_) {
        pg8::Gemm g{(const bf16*)(F.ws + WS_R2), (const bf16*)(F.ws + WS_WD), NT * 256, 1024, D}; pg8::MoeOrderSplit S; S.init(NT, 4, F.G, (int)blockIdx.x, 1024, (const LAS int*)(F.lds + TILE_E_OFF), (const int*)(F.ws + WS_LIST), LCAP);
        pg8::EpiDown E{F.ws + WS_R1, F.in[15], &S};
        pg8::gemm_phase<pg8::EpiDown, pg8::MoeOrderSplit, true, true, true>(F.lds + RING_OFF, g, S, E);
        if (rep_ + 1 < REPS(9)) GRID_BAR(); }
        if (BOTH(9)) GRID_BAR();
    }
    if (IN(10)) { REPEAT(10, p9_final(F)); }
#undef IN
#undef BOTH
}

extern "C" void kernel_launch(void* const* d_in, const int* in_sizes, int n_in, void* d_out, int out_size, void* d_ws, size_t ws_size, hipStream_t stream) {
    static int grid = 0;
    if (grid == 0) {
        if (n_in != 17 || in_sizes[0] != M * D || out_size != M * D || ws_size < WS_END) { fprintf(stderr, "kernel_launch: unexpected shapes (n_in %d, in0 %d, out %d, ws %zu); nothing launched\n", n_in, n_in > 0 ? in_sizes[0] : -1, out_size, ws_size); grid = -1; return; }
        int dev = 0, cus = 0, per_cu = 0;
        if (hipGetDevice(&dev) != hipSuccess || hipDeviceGetAttribute(&cus, hipDeviceAttributeMultiprocessorCount, dev) != hipSuccess) { grid = -1; return; }
        if (hipFuncSetAttribute((const void*)hymba_fwd, hipFuncAttributeMaxDynamicSharedMemorySize, LDS_BYTES) != hipSuccess) { fprintf(stderr, "kernel_launch: hipFuncSetAttribute failed\n"); grid = -1; return; }
        if (hipOccupancyMaxActiveBlocksPerMultiprocessor(&per_cu, (const void*)hymba_fwd, NWAVES * 64, LDS_BYTES) != hipSuccess || per_cu < 1)
            fprintf(stderr, "kernel_launch: note: occupancy query reports %d workgroups per CU\n", per_cu);
        (void)hipGetLastError();
        grid = cus;
        if (grid != 256) fprintf(stderr, "kernel_launch: note: %d CUs\n", grid);
    }
    if (grid < 0) return;
    if (hipMemsetAsync((char*)d_ws + WS_CTL, 0, CTL_ZERO_BYTES, stream) != hipSuccess) { fprintf(stderr, "kernel_launch: memset failed\n"); return; }
    Args a{};
    for (int i = 0; i < 17; ++i) a.in[i] = (const float*)d_in[i];
    a.out = (float*)d_out; a.ws = (unsigned char*)d_ws;
    if (N_LAUNCHES == 1) { a.ph_lo = 0; a.ph_hi = NPHASE; a.li = 0; hipLaunchKernelGGL(hymba_fwd, dim3(grid), dim3(NWAVES * 64), LDS_BYTES, stream, a); }
    else for (int li = 0; li < NPHASE; ++li) { a.ph_lo = li; a.ph_hi = li + 1; a.li = li; hipLaunchKernelGGL(hymba_fwd, dim3(grid), dim3(NWAVES * 64), LDS_BYTES, stream, a); }
    const hipError_t le = hipPeekAtLastError();
    if (le != hipSuccess) fprintf(stderr, "kernel_launch: launch failed: %s\n", hipGetErrorName(le));
}
```

```cpp
#include <hip/hip_runtime.h>
#include <cstdio>
#include <cstdint>

namespace pg8 {
#define PG8_LAS __attribute__((address_space(3)))
typedef unsigned short bf16_t;
typedef short bf16x8 __attribute__((ext_vector_type(8)));
typedef float f32x4 __attribute__((ext_vector_type(4)));
typedef unsigned u32x4 __attribute__((ext_vector_type(4)));
constexpr int BM = 256, BK = 64, HALF = 128, HTB = HALF * BK * 2  , STAGE_BYTES = 8 * HTB, NXCD = 8, WGM = 8;

__host__ __device__ __forceinline__ int lds_byte(int r, int c) { const int st = (r >> 4) * 2 + (c >> 5), rr = r & 15, cc = c & 31, ob = rr * 64 + cc * 2; return st * 1024 + (ob ^ (((ob >> 9) & 1) << 5)); }
__host__ __device__ __forceinline__ void stage_rc(int b, int& R, int& C) { const int st = b / 1024, sb = b % 1024, swz = sb ^ (((sb >> 9) & 1) << 5); R = (st >> 1) * 16 + swz / 64; C = (st & 1) * 32 + (swz % 64) / 2; }
__host__ __device__ __forceinline__ int perm32(int rho) { const int n = rho >> 4, i = rho & 15; return 8 * (i >> 2) + 4 * n + (i & 3); }

struct Unit { int pm, pn, pb, e, ui; };
struct Gemm { const bf16_t* A; const bf16_t* Bt; int M, N, K; };

struct StaticOrder {
    int nM, nN, nwg, G, c;
    __host__ __device__ void init(int M, int N, int G_, int c_) { nM = M / BM; nN = N / BM; nwg = nM * nN; G = G_; c = c_; }
    __host__ __device__ bool next(int i, Unit& u) const {
        const long L = (long)i * G + c; if (L >= nwg) return false;
        int wgid = (int)L; { const int q = nwg / NXCD, r = nwg % NXCD, xcd = wgid % NXCD, off = wgid / NXCD; wgid = (xcd < r ? xcd * (q + 1) : r * (q + 1) + (xcd - r) * q) + off; }
        const int nig = WGM * nN, gid = wgid / nig, fm = gid * WGM, gsz = (nM - fm) < WGM ? (nM - fm) : WGM;
        u.pm = fm + ((wgid % nig) % gsz); u.pn = (wgid % nig) / gsz; u.pb = u.pn * BM; u.e = 0; u.ui = i; return true;
    }
    __device__ __forceinline__ unsigned row_off(const Unit&, int) const { return 0u; }
    __device__ __forceinline__ void row_off4(const Unit&, const int (&)[4], unsigned (&o)[4]) const { o[0] = o[1] = o[2] = o[3] = 0u; }
    __device__ __forceinline__ void row_raw4(const Unit&, const int (&)[4], unsigned (&v)[4], bool (&ok)[4]) const { v[0] = v[1] = v[2] = v[3] = 0u; ok[0] = ok[1] = ok[2] = ok[3] = false; }
    __device__ __forceinline__ void a_ready(const Unit&) const {}
    __device__ __forceinline__ void done(const Unit&) const {}
};
struct MoeOrder {
    int nM, nN, nwg, G, c, NB; const PG8_LAS int* tile_e; const PG8_LAS int* rowbase; const PG8_LAS int* cnt; const int* list; int lcap;
    __device__ void init(int nM_, int nN_, int G_, int c_, int NB_, const PG8_LAS int* te, const int* list_, int lcap_) { nM = nM_; nN = nN_; nwg = nM * nN; G = G_; c = c_; NB = NB_; tile_e = te; rowbase = te + 288; cnt = te + 320; list = list_; lcap = lcap_; }
    __device__ bool next(int i, Unit& u) const {
        const long L = (long)i * G + c; if (L >= nwg) return false;
        int wgid = (int)L; { const int q = nwg / NXCD, r = nwg % NXCD, xcd = wgid % NXCD, off = wgid / NXCD; wgid = (xcd < r ? xcd * (q + 1) : r * (q + 1) + (xcd - r) * q) + off; }
        const int nig = WGM * nN, gid = wgid / nig, fm = gid * WGM, gsz = (nM - fm) < WGM ? (nM - fm) : WGM;
        u.pm = fm + ((wgid % nig) % gsz); u.pn = (wgid % nig) / gsz; u.e = tile_e[u.pm]; u.pb = u.e * NB + u.pn * BM; u.ui = i; return true;
    }
    __device__ __forceinline__ unsigned row_entry(const Unit& u, int r) const { const int p = u.pm * BM + r - rowbase[u.e]; const bool ok = p < cnt[u.e];
        const unsigned v = (unsigned)list[(size_t)u.e * lcap + (ok ? p : 0)]; return ok ? v : 0xffffffffu; }
    __device__ __forceinline__ unsigned row_off(const Unit& u, int r) const { const unsigned s = row_entry(u, r); return s == 0xffffffffu ? 0u : ((s & 0xffffu) >> 2); }
    __device__ __forceinline__ void row_off4(const Unit& u, const int (&r)[4], unsigned (&o)[4]) const {
        const int rb = rowbase[u.e], cn = cnt[u.e]; unsigned v[4]; bool ok[4];
#pragma unroll
        for (int q = 0; q < 4; ++q) { const int p = u.pm * BM + r[q] - rb; ok[q] = p < cn; v[q] = (unsigned)list[(size_t)u.e * lcap + (ok[q] ? p : 0)]; }
#pragma unroll
        for (int q = 0; q < 4; ++q) o[q] = ok[q] ? ((v[q] & 0xffffu) >> 2) : 0u;
    }
    __device__ __forceinline__ void row_raw4(const Unit& u, const int (&r)[4], unsigned (&v)[4], bool (&ok)[4]) const {
        const int rb = rowbase[u.e], cn = cnt[u.e];
#pragma unroll
        for (int q = 0; q < 4; ++q) { const int p = u.pm * BM + r[q] - rb; ok[q] = p < cn; v[q] = (unsigned)list[(size_t)u.e * lcap + (ok[q] ? p : 0)]; }
    }
    __device__ __forceinline__ void row_entry_raw(const Unit& u, int r, unsigned& v, bool& ok) const { const int p = u.pm * BM + r - rowbase[u.e]; ok = p < cnt[u.e]; v = (unsigned)list[(size_t)u.e * lcap + (ok ? p : 0)]; }
    __device__ __forceinline__ void a_ready(const Unit&) const {}
    __device__ __forceinline__ void done(const Unit&) const {}
};

__device__ __forceinline__ unsigned cvt_pk_bf16(float lo, float hi) { unsigned r; asm volatile("v_cvt_pk_bf16_f32 %0, %1, %2" : "=v"(r) : "v"(lo), "v"(hi)); return r; }

struct NoPre {};
struct EpiProj {
    static constexpr bool PERM = true, AFTER_DRAIN = false;
    typedef NoPre Pre; __device__ __forceinline__ void pre(Pre&, const Unit&, int, int, int, int) const {}
    struct Bias {}; static constexpr bool ACC_BIAS = false; __device__ __forceinline__ void load_bias(Bias&, const Unit&, int, int) const {}
    bf16_t* P;
    __device__ __forceinline__ void operator()(const f32x4 (&acc)[2][2][4][2], const Unit& u, int wr, int wc, int fr, int fq, const Pre&) const {
        const int row0 = u.pm * BM + wr * 64 + fr;
        {
            const int col0 = u.pn * BM + wc * 32 + 8 * fq;
#pragma unroll
            for (int ai = 0; ai < 2; ++ai)
#pragma unroll
                for (int m = 0; m < 4; ++m) { bf16_t* rowp = P + (size_t)(row0 + ai * HALF + m * 16) * 4096 + col0;
#pragma unroll
                    for (int bj = 0; bj < 2; ++bj) { const f32x4 v0 = acc[ai][bj][m][0], v1 = acc[ai][bj][m][1];
                        u32x4 w; w.x = cvt_pk_bf16(v0[0], v0[1]); w.y = cvt_pk_bf16(v0[2], v0[3]); w.z = cvt_pk_bf16(v1[0], v1[1]); w.w = cvt_pk_bf16(v1[2], v1[3]);
                        *(u32x4*)(rowp + bj * HALF) = w; } }
        }
    }
};
struct EpiResF32 {
    static constexpr bool PERM = false, AFTER_DRAIN = false;
    typedef NoPre Pre; __device__ __forceinline__ void pre(Pre&, const Unit&, int, int, int, int) const {}
    struct Bias {}; static constexpr bool ACC_BIAS = false; __device__ __forceinline__ void load_bias(Bias&, const Unit&, int, int) const {}
    const float* base; bf16_t* out; float* rowss;
    __device__ __forceinline__ void operator()(const f32x4 (&acc)[2][2][4][2], const Unit& u, int wr, int wc, int fr, int fq, const Pre&) const {
        const int row0 = u.pm * BM + wr * 64 + fr, col0 = u.pn * BM + wc * 32 + 4 * fq;
#pragma unroll
        for (int ai = 0; ai < 2; ++ai) {
            f32x4 bs[4][2][2];
#pragma unroll
            for (int m = 0; m < 4; ++m) { const size_t off = (size_t)(row0 + ai * HALF + m * 16) * 1024 + col0;
#pragma unroll
                for (int bj = 0; bj < 2; ++bj)
#pragma unroll
                    for (int n = 0; n < 2; ++n) bs[m][bj][n] = *(const f32x4*)(base + off + bj * HALF + n * 16); }
            __builtin_amdgcn_sched_barrier(0);
#pragma unroll
            for (int m = 0; m < 4; ++m) { const size_t off = (size_t)(row0 + ai * HALF + m * 16) * 1024 + col0; float ss = 0.f;
#pragma unroll
                for (int bj = 0; bj < 2; ++bj)
#pragma unroll
                    for (int n = 0; n < 2; ++n) { const f32x4 o = bs[m][bj][n] + acc[ai][bj][m][n]; typedef unsigned u32x2 __attribute__((ext_vector_type(2)));
                        u32x2 ob; ob.x = cvt_pk_bf16(o[0], o[1]); ob.y = cvt_pk_bf16(o[2], o[3]); *(u32x2*)(out + off + bj * HALF + n * 16) = ob;
                        ss += (o[0] * o[0] + o[1] * o[1]) + (o[2] * o[2] + o[3] * o[3]); }
                ss += __shfl_xor(ss, 16); ss += __shfl_xor(ss, 32);
                if (fq == 0) rowss[(size_t)(row0 + ai * HALF + m * 16) * 16 + u.pn * 4 + wc] = ss; }
        }
    }
};
__device__ __forceinline__ unsigned pk4_fp8(float a, float b, float c, float d) { int p = __builtin_amdgcn_cvt_pk_fp8_f32(a, b, 0, false); p = __builtin_amdgcn_cvt_pk_fp8_f32(c, d, p, true); return (unsigned)p; }
struct EpiDown {
    static constexpr bool PERM = true, AFTER_DRAIN = false;
    unsigned char* ys; const float* bd; const MoeOrder* ord;
    struct Bias { f32x4 v[2][2]; }; static constexpr bool ACC_BIAS = true;
    __device__ __forceinline__ void load_bias(Bias& b, const Unit& u, int wc, int fq) const {
#pragma unroll
        for (int bj = 0; bj < 2; ++bj)
#pragma unroll
            for (int n = 0; n < 2; ++n) b.v[bj][n] = *(const f32x4*)(bd + (size_t)u.e * 1024 + u.pn * BM + bj * HALF + wc * 32 + 8 * fq + 4 * n); }
    struct Pre { unsigned ent[2][4]; unsigned okm; };
    __device__ __forceinline__ void pre(Pre& p, const Unit& u, int wr, int wc, int fr, int fq) const {
        unsigned okm = 0u;
#pragma unroll
        for (int ai = 0; ai < 2; ++ai)
#pragma unroll
            for (int m = 0; m < 4; ++m) { bool ok; ord->row_entry_raw(u, wr * 64 + fr + ai * HALF + m * 16, p.ent[ai][m], ok); okm |= ok ? (1u << (ai * 4 + m)) : 0u; }
        p.okm = okm;
    }
    __device__ __forceinline__ void operator()(const f32x4 (&acc)[2][2][4][2], const Unit& u, int wr, int wc, int fr, int fq, const Pre& p) const {
        typedef unsigned u32x2 __attribute__((ext_vector_type(2)));
        const int c0 = u.pn * BM + wc * 32 + 8 * fq;
        unsigned en8[2][4]; unsigned okm = p.okm;
#pragma unroll
        for (int ai = 0; ai < 2; ++ai)
#pragma unroll
            for (int m = 0; m < 4; ++m) en8[ai][m] = p.ent[ai][m];
        asm volatile("" : "+v"(en8[0][0]), "+v"(en8[0][1]), "+v"(en8[0][2]), "+v"(en8[0][3]), "+v"(en8[1][0]), "+v"(en8[1][1]), "+v"(en8[1][2]), "+v"(en8[1][3]), "+v"(okm));
#pragma unroll
        for (int ai = 0; ai < 2; ++ai)
#pragma unroll
            for (int m = 0; m < 4; ++m) { const unsigned en = en8[ai][m];
                if ((okm >> (ai * 4 + m)) & 1u) { const unsigned tk = en & 0xffffu; const float w = __builtin_bit_cast(float, en & 0xffff0000u) * 8.0f;
#pragma unroll
                    for (int bj = 0; bj < 2; ++bj) { f32x4 v0 = acc[ai][bj][m][0] * w, v1 = acc[ai][bj][m][1] * w;
#pragma unroll
                        for (int q = 0; q < 4; ++q) { v0[q] = fminf(fmaxf(v0[q], -448.0f), 448.0f); v1[q] = fminf(fmaxf(v1[q], -448.0f), 448.0f); }
                        u32x2 o; o.x = pk4_fp8(v0[0], v0[1], v0[2], v0[3]); o.y = pk4_fp8(v1[0], v1[1], v1[2], v1[3]);
                        *(u32x2*)(ys + (size_t)tk * 1024 + c0 + bj * HALF) = o; } } }
    }
};

typedef int i32x8 __attribute__((ext_vector_type(8)));
constexpr float W8_SCALE = 64.0f;
constexpr float SWI_C = -1.702f * 1.44269504089f;
__device__ __forceinline__ f32x4 mma_f8(bf16x8 b0, bf16x8 b1, bf16x8 a0, bf16x8 a1, f32x4 c) {
    typedef int i32x4 __attribute__((ext_vector_type(4)));
    const i32x8 x = __builtin_shufflevector(__builtin_bit_cast(i32x4, b0), __builtin_bit_cast(i32x4, b1), 0, 1, 2, 3, 4, 5, 6, 7);
    const i32x8 y = __builtin_shufflevector(__builtin_bit_cast(i32x4, a0), __builtin_bit_cast(i32x4, a1), 0, 1, 2, 3, 4, 5, 6, 7);
    const int sw = 0x79797979, sa = 0x7f7f7f7f;
    asm volatile("v_mfma_scale_f32_16x16x128_f8f6f4 %0, %1, %2, %0, %3, %4 op_sel_hi:[0,0,0]" : "+v"(c) : "v"(x), "v"(y), "v"(sw), "v"(sa));
    return c;
}
#define PG8_MFMA_DRAIN() do { __builtin_amdgcn_sched_barrier(0); asm volatile("s_nop 7\n\ts_nop 7\n\ts_nop 7" ::: "memory"); __builtin_amdgcn_sched_barrier(0); } while (0)
struct EpiSwigluF8 {
    static constexpr bool PERM = true, AFTER_DRAIN = false;
    unsigned char* act; const float* bgu;
    struct Bias { f32x4 v[2][2]; }; static constexpr bool ACC_BIAS = true;
    __device__ __forceinline__ void load_bias(Bias& b, const Unit& u, int wc, int fq) const {
#pragma unroll
        for (int bj = 0; bj < 2; ++bj)
#pragma unroll
            for (int n = 0; n < 2; ++n) { const f32x4 r = *(const f32x4*)(bgu + (size_t)u.e * 2048 + bj * 1024 + u.pn * HALF + wc * 32 + 8 * fq + 4 * n);
                b.v[bj][n] = bj == 0 ? r * SWI_C : (r + 1.0f) * (1.0f / SWI_C); } }
    typedef NoPre Pre;
    __device__ __forceinline__ void pre(Pre&, const Unit&, int, int, int, int) const {}
    __device__ __forceinline__ void operator()(const f32x4 (&acc)[2][2][4][2], const Unit& u, int wr, int wc, int fr, int fq, const Pre&) const {
        const int row0 = u.pm * BM + wr * 64 + fr, c0 = u.pn * HALF + wc * 32 + 8 * fq;
#pragma unroll
        for (int ai = 0; ai < 2; ++ai)
#pragma unroll
            for (int m = 0; m < 4; ++m) { float r[8];
#pragma unroll
                for (int n = 0; n < 2; ++n)
#pragma unroll
                    for (int j = 0; j < 4; ++j) { float g = acc[ai][0][m][n][j], up = acc[ai][1][m][n][j];
                        asm("v_max_f32 %0, %1, %2" : "=v"(g) : "s"(7.0f * SWI_C), "v"(g)); up = __builtin_amdgcn_fmed3f(up, 8.0f / SWI_C, -6.0f / SWI_C);
                        const float sg = __builtin_amdgcn_rcpf(1.0f + __builtin_amdgcn_exp2f(g)); r[4 * n + j] = up * g * sg; }
                typedef unsigned u32x2 __attribute__((ext_vector_type(2)));
                u32x2 w; w.x = pk4_fp8(r[0], r[1], r[2], r[3]); w.y = pk4_fp8(r[4], r[5], r[6], r[7]);
                *(u32x2*)(act + (size_t)(row0 + ai * HALF + m * 16) * 1024 + c0) = w; }
    }
};

template <class Epi, class Sched, bool ALIGN_EPI = false, bool SP2 = false, bool F8 = false, bool GATHER = false>
__device__ __forceinline__ void gemm_phase(PG8_LAS unsigned char* lds, const Gemm g, const Sched& S, const Epi& E) {
    const int tid = threadIdx.x, wid = __builtin_amdgcn_readfirstlane(tid >> 6), lane = tid & 63, wr = wid >> 2, wc = wid & 3, fr = lane & 15, fq = lane >> 4;
    const int K = g.K, RB = F8 ? K : 2 * K  , nt = RB / (BK * 2);
    unsigned voffA[2], voffB[2];
#pragma unroll
    for (int i = 0; i < 2; ++i) { int R, C; stage_rc(tid * 16 + i * 8192, R, C); const int Rb = Epi::PERM ? ((R & ~31) + perm32(R & 31)) : R;
        voffA[i] = (unsigned)(R * RB + C * 2); voffB[i] = (unsigned)(Rb * RB + C * 2); }
    const size_t kstep = (size_t)(BK * 2);
    const size_t hstep = (size_t)HALF * RB;
    const size_t tstep = 2 * hstep;
    const unsigned ldsw = (unsigned)wid * 1024u;
    const int aoff = lds_byte(wr * 64 + fr, fq * 8), boff = lds_byte(wc * 32 + fr, fq * 8);
#define PG8_SA(b, h) (((b) * 2 + (h)) * HTB)
#define PG8_SB(b, h) ((4 + (b) * 2 + (h)) * HTB)
#define PG8_STAGE(bufoff, gbase, voff) do { _Pragma("unroll") for (int _i = 0; _i < 2; ++_i) \
        __builtin_amdgcn_global_load_lds((const unsigned*)((const char*)(gbase) + (voff)[_i]), (PG8_LAS unsigned*)(lds + (bufoff) + ldsw + _i * 8192), 16, 0, 0); } while (0)
#define PG8_STAGE_A(bufoff, gbase, h, usenext) do { _Pragma("unroll") for (int _i = 0; _i < 2; ++_i) { \
        const unsigned _vo = GATHER ? ((usenext) ? nvA[h][_i] : cvA[h][_i]) : voffA[_i]; \
        __builtin_amdgcn_global_load_lds((const unsigned*)((const char*)(gbase) + (GATHER ? (size_t)0 : (size_t)(h) * hstep) + _vo), (PG8_LAS unsigned*)(lds + (bufoff) + ldsw + _i * 8192), 16, 0, 0); } } while (0)
#define PG8_LDA(dst, b, h) do { _Pragma("unroll") for (int m = 0; m < 4; ++m) _Pragma("unroll") for (int k = 0; k < 2; ++k) dst[m][k] = *(const PG8_LAS bf16x8*)(lds + PG8_SA(b, h) + aoff + m * 2048 + k * 1024); } while (0)
#define PG8_LDB(dst, b, h) do { _Pragma("unroll") for (int n = 0; n < 2; ++n) _Pragma("unroll") for (int k = 0; k < 2; ++k) dst[n][k] = *(const PG8_LAS bf16x8*)(lds + PG8_SB(b, h) + boff + n * 2048 + k * 1024); } while (0)
#define PG8_MMA(ai, bj, At, Bt) do { __builtin_amdgcn_s_setprio(1); _Pragma("unroll") for (int m = 0; m < 4; ++m) _Pragma("unroll") for (int n = 0; n < 2; ++n) { \
        if constexpr (F8) { acc[ai][bj][m][n] = mma_f8(Bt[n][0], Bt[n][1], At[m][0], At[m][1], acc[ai][bj][m][n]); } \
        else { _Pragma("unroll") for (int k = 0; k < 2; ++k) acc[ai][bj][m][n] = __builtin_amdgcn_mfma_f32_16x16x32_bf16(Bt[n][k], At[m][k], acc[ai][bj][m][n], 0, 0, 0); } } \
        __builtin_amdgcn_s_setprio(0); } while (0)
#define PG8_WAIT_V(n) asm volatile("s_waitcnt vmcnt(" #n ")" ::: "memory")
#define PG8_WAIT_L(n) asm volatile("s_waitcnt lgkmcnt(" #n ")" ::: "memory")
#define PG8_BAR __builtin_amdgcn_s_barrier()
#define PG8_SCHED __builtin_amdgcn_sched_barrier(0)
    Unit cur, nxt, nx2; int ui = 0;
    if (!S.next(0, cur)) return;
    bool has_next = S.next(1, nxt);
    unsigned nraw[4] = {0u, 0u, 0u, 0u}; bool nok[4] = {false, false, false, false};
    f32x4 acc[2][2][4][2];
    typename Epi::Bias nb; E.load_bias(nb, cur, wc, fq);
    bf16x8 At[4][2], B0[2][2], B1[2][2];
    const char* cA = GATHER ? (const char*)g.A : (const char*)g.A + (size_t)cur.pm * tstep; const char* cB = (const char*)g.Bt + (size_t)cur.pb * (size_t)RB;
    unsigned cvA[2][2] = {{0u, 0u}, {0u, 0u}}, nvA[2][2] = {{0u, 0u}, {0u, 0u}};
    int gR[2] = {0, 0}, gC[2] = {0, 0};
    if constexpr (GATHER) {
#pragma unroll
        for (int i = 0; i < 2; ++i) stage_rc(tid * 16 + i * 8192, gR[i], gC[i]);
        { const int rr[4] = {gR[0], gR[1], HALF + gR[0], HALF + gR[1]}; unsigned ro[4]; S.row_off4(cur, rr, ro);
#pragma unroll
          for (int h = 0; h < 2; ++h)
#pragma unroll
              for (int i = 0; i < 2; ++i) cvA[h][i] = ro[2 * h + i] * (unsigned)RB + (unsigned)(gC[i] * 2);
          if (has_next) S.row_raw4(nxt, rr, nraw, nok); }
    }
    S.a_ready(cur);
    typename Epi::Pre epre; E.pre(epre, cur, wr, wc, fr, fq);
    if constexpr (SP2) {
        PG8_STAGE(PG8_SB(0, 0), cB, voffB); PG8_STAGE(PG8_SB(0, 1), cB + hstep, voffB); PG8_STAGE_A(PG8_SA(0, 0), cA, 0, false); PG8_STAGE_A(PG8_SA(0, 1), cA, 1, false);
        if (wr == 1) PG8_BAR;
        PG8_WAIT_V(2); PG8_BAR;
        PG8_STAGE(PG8_SB(1, 0), cB + kstep, voffB); PG8_STAGE_A(PG8_SA(1, 0), cA + kstep, 0, false); PG8_STAGE(PG8_SB(1, 1), cB + hstep + kstep, voffB);
        PG8_WAIT_V(6); PG8_BAR;
    } else {
        PG8_STAGE(PG8_SB(0, 0), cB, voffB); PG8_STAGE_A(PG8_SA(0, 0), cA, 0, false); PG8_STAGE(PG8_SB(0, 1), cB + hstep, voffB); PG8_STAGE_A(PG8_SA(0, 1), cA, 1, false);
        if (wr == 1) PG8_BAR;
        PG8_WAIT_V(4); PG8_BAR;
        PG8_STAGE(PG8_SB(1, 0), cB + kstep, voffB); PG8_STAGE_A(PG8_SA(1, 0), cA + kstep, 0, false); PG8_STAGE(PG8_SB(1, 1), cB + hstep + kstep, voffB);
        PG8_WAIT_V(6); PG8_BAR;
    }
#pragma unroll
    for (int a = 0; a < 2; ++a)
#pragma unroll
        for (int b = 0; b < 2; ++b)
#pragma unroll
            for (int m = 0; m < 4; ++m)
#pragma unroll
                for (int n = 0; n < 2; ++n) { if constexpr (Epi::ACC_BIAS) acc[a][b][m][n] = nb.v[b][n]; else acc[a][b][m][n] = (f32x4){0.f, 0.f, 0.f, 0.f}; }
    for (;;) {
        const char* nA = GATHER ? cA : (has_next ? (const char*)g.A + (size_t)nxt.pm * tstep : cA); const char* nB = has_next ? (const char*)g.Bt + (size_t)nxt.pb * (size_t)RB : cB;
        if constexpr (GATHER) {
            if (has_next) {
#pragma unroll
                for (int h = 0; h < 2; ++h)
#pragma unroll
                    for (int i = 0; i < 2; ++i) { const unsigned ro = nok[2 * h + i] ? ((nraw[2 * h + i] & 0xffffu) >> 2) : 0u; nvA[h][i] = ro * (unsigned)RB + (unsigned)(gC[i] * 2); } }
            else {
#pragma unroll
                for (int h = 0; h < 2; ++h)
#pragma unroll
                    for (int i = 0; i < 2; ++i) nvA[h][i] = cvA[h][i]; }
        }
        for (int t = 0; t < nt; t += 2) {
            const bool last = (t == nt - 2);
            const char* a1 = cA + (size_t)(t + 1) * kstep;
            const char* a2 = last ? nA : cA + (size_t)(t + 2) * kstep; const char* b2 = last ? nB : cB + (size_t)(t + 2) * kstep;
            const char* a3 = a2 + kstep; const char* b3 = b2 + kstep;
            if (last && has_next) S.a_ready(nxt);
            if constexpr (SP2) {
            PG8_LDB(B0, 0, 0); PG8_LDB(B1, 0, 1); PG8_SCHED; PG8_LDA(At, 0, 0); PG8_STAGE_A(PG8_SA(1, 1), a1, 1, false);
            PG8_WAIT_V(8); PG8_WAIT_L(0); PG8_BAR; PG8_MMA(0, 0, At, B0); PG8_MMA(0, 1, At, B1); PG8_BAR; PG8_SCHED;
            PG8_LDA(At, 0, 1); PG8_STAGE(PG8_SB(0, 0), b2, voffB); PG8_STAGE(PG8_SB(0, 1), b2 + hstep, voffB); PG8_STAGE_A(PG8_SA(0, 0), a2, 0, last);
            PG8_WAIT_V(8); PG8_WAIT_L(0); PG8_BAR; PG8_MMA(1, 0, At, B0); PG8_MMA(1, 1, At, B1); PG8_BAR; PG8_SCHED;
            PG8_LDB(B0, 1, 0); PG8_LDB(B1, 1, 1); PG8_SCHED; PG8_LDA(At, 1, 0); PG8_STAGE_A(PG8_SA(0, 1), a2, 1, last);
            PG8_WAIT_V(8); PG8_WAIT_L(0); PG8_BAR; PG8_MMA(0, 0, At, B0); PG8_MMA(0, 1, At, B1); PG8_BAR; PG8_SCHED;
            PG8_LDA(At, 1, 1); PG8_STAGE(PG8_SB(1, 0), b3, voffB); PG8_STAGE(PG8_SB(1, 1), b3 + hstep, voffB); PG8_STAGE_A(PG8_SA(1, 0), a3, 0, last);
            PG8_WAIT_V(8); PG8_WAIT_L(0); PG8_BAR; PG8_MMA(1, 0, At, B0); PG8_MMA(1, 1, At, B1); PG8_BAR; PG8_SCHED;
            } else {
            PG8_LDB(B0, 0, 0); PG8_SCHED; PG8_LDA(At, 0, 0); PG8_STAGE_A(PG8_SA(1, 1), a1, 1, false);
            PG8_WAIT_L(8); PG8_BAR; PG8_WAIT_L(0); PG8_MMA(0, 0, At, B0); PG8_BAR; PG8_SCHED;
            PG8_LDB(B1, 0, 1); PG8_STAGE(PG8_SB(0, 0), b2, voffB);
            PG8_BAR; PG8_WAIT_L(0); PG8_MMA(0, 1, At, B1); PG8_BAR;
            PG8_LDA(At, 0, 1); PG8_STAGE_A(PG8_SA(0, 0), a2, 0, last);
            PG8_BAR; PG8_WAIT_L(0); PG8_MMA(1, 0, At, B0); PG8_BAR; PG8_SCHED;
            PG8_STAGE(PG8_SB(0, 1), b2 + hstep, voffB);
            PG8_WAIT_V(6); PG8_BAR; PG8_MMA(1, 1, At, B1); PG8_BAR;
            PG8_LDB(B0, 1, 0); PG8_SCHED; PG8_LDA(At, 1, 0); PG8_STAGE_A(PG8_SA(0, 1), a2, 1, last);
            PG8_WAIT_L(8); PG8_BAR; PG8_WAIT_L(0); PG8_MMA(0, 0, At, B0); PG8_BAR; PG8_SCHED;
            PG8_LDB(B1, 1, 1); PG8_STAGE(PG8_SB(1, 0), b3, voffB);
            PG8_BAR; PG8_WAIT_L(0); PG8_MMA(0, 1, At, B1); PG8_BAR;
            PG8_LDA(At, 1, 1); PG8_STAGE_A(PG8_SA(1, 0), a3, 0, last);
            PG8_BAR; PG8_WAIT_L(0); PG8_MMA(1, 0, At, B0); PG8_BAR; PG8_SCHED;
            PG8_STAGE(PG8_SB(1, 1), b3 + hstep, voffB);
            PG8_WAIT_V(6); PG8_BAR; PG8_MMA(1, 1, At, B1); PG8_BAR;
            }
        }
        bool has_nx2 = false; if (has_next) has_nx2 = S.next(ui + 2, nx2);
        if constexpr (GATHER) { if (has_nx2) { const int rr[4] = {gR[0], gR[1], HALF + gR[0], HALF + gR[1]}; S.row_raw4(nx2, rr, nraw, nok); } }
        if constexpr (ALIGN_EPI) { if (wr == 0) PG8_BAR; }
        if constexpr (F8) { PG8_MFMA_DRAIN(); }
        if constexpr (Epi::ACC_BIAS) { Unit bu = cur; if (has_next) { bu.e = nxt.e; bu.pn = nxt.pn; } E.load_bias(nb, bu, wc, fq); }
        if constexpr (!Epi::AFTER_DRAIN) { E(acc, cur, wr, wc, fr, fq, epre); S.done(cur); if (has_next) E.pre(epre, nxt, wr, wc, fr, fq); }
        if (!has_next) break;
#pragma unroll
        for (int a = 0; a < 2; ++a)
#pragma unroll
            for (int b = 0; b < 2; ++b)
#pragma unroll
                for (int m = 0; m < 4; ++m)
#pragma unroll
                    for (int n = 0; n < 2; ++n) { if constexpr (Epi::ACC_BIAS) acc[a][b][m][n] = nb.v[b][n]; else acc[a][b][m][n] = (f32x4){0.f, 0.f, 0.f, 0.f}; }
        cur = nxt; nxt = nx2; has_next = has_nx2; cA = nA; cB = nB; ++ui;
        if constexpr (GATHER) {
#pragma unroll
            for (int h = 0; h < 2; ++h)
#pragma unroll
                for (int i = 0; i < 2; ++i) cvA[h][i] = nvA[h][i];
        }
        if constexpr (ALIGN_EPI) { if (wr == 1) PG8_BAR; }
    }
    PG8_WAIT_V(0);
    if constexpr (!ALIGN_EPI) { if (wr == 0) PG8_BAR; }
    PG8_BAR;
    if constexpr (Epi::AFTER_DRAIN) { E.fused(acc, cur, wr, wc, fr, fq, lds, wid, lane); S.done(cur); }
#undef PG8_SA
#undef PG8_SB
#undef PG8_STAGE
#undef PG8_STAGE_A
#undef PG8_LDA
#undef PG8_LDB
#undef PG8_MMA
#undef PG8_WAIT_V
#undef PG8_WAIT_L
#undef PG8_BAR
#undef PG8_SCHED
}
}


constexpr int NWAVES = 8;
#ifndef MK_N_LAUNCHES
#define MK_N_LAUNCHES 1
#endif
constexpr int NPHASE = 11;
constexpr int N_LAUNCHES = MK_N_LAUNCHES;

constexpr int BATCH = 4, SEQ = 4096, D = 1024, NMETA = 16;
constexpr int M = BATCH * SEQ;
constexpr int INC = 4096;
constexpr int C_QA = 0, C_KA = 512, C_VA = 1024, C_QH = 1536, C_IH = 2048, C_FF = 2560, C_FB = 3072, C_GH = 3584;
constexpr int NE = 32, TOPK = 4;
constexpr float RMS_EPS = 1e-6f;
constexpr int XROWS_MAX = 73728;
constexpr int NTILE_MAX = 288;
constexpr int LCAP = 16384;

constexpr size_t MiB = 1u << 20;
constexpr size_t WS_CTL = 0, CTL_ZERO_BYTES = 65536;
constexpr size_t WS_WIN = 1 * MiB;
constexpr size_t WS_WOUT = 9 * MiB;
constexpr size_t WS_WGU = 11 * MiB;
constexpr size_t WS_WD = 139 * MiB;
constexpr size_t WS_XN = 203 * MiB;
constexpr size_t WS_R1 = 235 * MiB;
constexpr size_t WS_R2 = 395 * MiB;
constexpr size_t R2_HQ = 0, R2_HK = 32 * MiB, R2_HV = 64 * MiB, R2_HA = 96 * MiB, R2_HD = 112 * MiB, R2_META = 113 * MiB, R2_OF = 116 * MiB, R2_OB = 148 * MiB;
constexpr size_t WS_Y = 575 * MiB;
constexpr size_t WS_HMID = 607 * MiB;
constexpr size_t WS_XN2 = 671 * MiB;
constexpr size_t WS_LIST = 703 * MiB;
constexpr size_t WS_PROJM = 706 * MiB + 512 * 1024;
constexpr size_t WS_XNM = 706 * MiB + 768 * 1024;
constexpr size_t WS_WRT = 708 * MiB;
constexpr size_t WS_ROWSS = 709 * MiB;
constexpr size_t WS_END = 710 * MiB;
constexpr int HU_Q = 64 * 128, HU_K = 128 * 64, HU_V = 128 * 64, HU_A = 64 * 64, HU_D = 128;

constexpr int CW_TMO = 0, CW_CODE = 1;
constexpr int CW_CNT = 64;
constexpr int CW_BAR = 4096;

constexpr int RING_OFF = 0, RING_BYTES = 131072;
constexpr int LDSCTL_OFF = 155648, MISC_OFF = LDSCTL_OFF + 320;
constexpr int TILE_E_OFF = LDSCTL_OFF + 512;
constexpr int LDS_BYTES = 163840;
static_assert(TILE_E_OFF + (NTILE_MAX + 96) * 4 <= LDS_BYTES, "LDS map");
#define GAS __attribute__((address_space(1)))
#define LAS __attribute__((address_space(3)))
typedef unsigned short bf16;
typedef unsigned v4u __attribute__((ext_vector_type(4)));
typedef float f32x4 __attribute__((ext_vector_type(4)));
typedef short bf16x8 __attribute__((ext_vector_type(8)));
typedef GAS unsigned gu32;
typedef GAS unsigned long long gu64;
#define RLX_AGENT __ATOMIC_RELAXED, __HIP_MEMORY_SCOPE_AGENT
#define LDS_WAIT() asm volatile("s_waitcnt lgkmcnt(0)" ::: "memory")
#define VM_WAIT() asm volatile("s_waitcnt vmcnt(0)" ::: "memory")
__device__ __forceinline__ unsigned long long rt() { return __builtin_amdgcn_s_memrealtime(); }
__device__ __forceinline__ unsigned pk2(float lo, float hi) { typedef float f2_t_ __attribute__((ext_vector_type(2))); typedef __bf16 b2_t_ __attribute__((ext_vector_type(2))); f2_t_ v = {lo, hi}; b2_t_ b = __builtin_convertvector(v, b2_t_); return __builtin_bit_cast(unsigned, b); }
__device__ __forceinline__ unsigned f2bf(float f) { return pk2(f, f) & 0xffffu; }

#define XB_TMO      128
#define XB_XCNT(j)  (256  + 64 * (j))
#define XB_XSUB(j)  (1280 + 64 * (j))
#define XB_XGEN(j)  (2304 + 64 * (j))
#define XB_TOP      3328
#define XB_TOPGEN   3392
#define XCD_BAR_WORDS 3456
#define XB_SPIN_CAP (1u << 18)

__device__ __forceinline__ unsigned xb_ld(unsigned* p)              { return __hip_atomic_load(p, __ATOMIC_RELAXED, __HIP_MEMORY_SCOPE_AGENT); }
__device__ __forceinline__ unsigned xb_add(unsigned* p, unsigned v) { return __hip_atomic_fetch_add(p, v, __ATOMIC_RELAXED, __HIP_MEMORY_SCOPE_AGENT); }
__device__ __forceinline__ unsigned xb_xcc_id() { return (unsigned)__builtin_amdgcn_s_getreg((3 << 11) | 20) & 0xFu; }
#define XB_SPIN(cond, bar) do { unsigned _sp = 0; while (cond) { __builtin_amdgcn_s_sleep(1); \
    if ((++_sp & 255u) == 0u) { if (xb_ld(&(bar)[XB_TMO])) break; if (_sp > XB_SPIN_CAP) { atomicAdd(&(bar)[XB_TMO], 1u); break; } } } } while (0)

struct XcdBarrier {
    unsigned* bar; unsigned x;
    volatile LAS unsigned* st;
};

__device__ __forceinline__ XcdBarrier xcd_barrier_post(unsigned* bar, volatile LAS unsigned* st) {
    XcdBarrier b; b.bar = bar; b.x = xb_xcc_id(); b.st = st;
    if (threadIdx.x == 0) (void)xb_add(&bar[XB_XCNT(b.x)], 1u);
    return b;
}
__device__ __forceinline__ void xcd_barrier_complete(unsigned* bar, unsigned x, unsigned& nloc, unsigned& nx) {
    const unsigned G = gridDim.x * gridDim.y * gridDim.z;
    unsigned sum, cnt, mine, sp = 0u;
    for (;;) {
        sum = 0u; cnt = 0u; mine = 0u;
#pragma unroll
        for (unsigned j = 0; j < 16; ++j) { const unsigned c = xb_ld(&bar[XB_XCNT(j)]); sum += c; cnt += (c > 0u) ? 1u : 0u; mine = (j == x) ? c : mine; }
        if (sum == G) break;
        __builtin_amdgcn_s_sleep(1);
        if ((++sp & 255u) == 0u) { if (xb_ld(&bar[XB_TMO])) break; if (sp > XB_SPIN_CAP) { atomicAdd(&bar[XB_TMO], 1u); break; } }
    }
    nloc = mine > 0u ? mine : 1u; nx = cnt > 0u ? cnt : 1u;
}

__device__ __forceinline__ void xcd_barrier(const XcdBarrier& b) {
    asm volatile("s_waitcnt vmcnt(0)" ::: "memory");
    __syncthreads();
    if (threadIdx.x == 0) {
        unsigned* bar = b.bar;
        __builtin_amdgcn_s_waitcnt(0);
        unsigned nloc = b.st[0], nx = b.st[1];
        if (nloc == 0u) { xcd_barrier_complete(bar, b.x, nloc, nx); b.st[0] = nloc; b.st[1] = nx; }
        const unsigned old = xb_add(&bar[XB_XSUB(b.x)], 1u);
        const unsigned gen = old / nloc;
        if (old + 1u == (gen + 1u) * nloc) {
            __builtin_amdgcn_fence(__ATOMIC_RELEASE, "agent");
            asm volatile("s_waitcnt vmcnt(0)" ::: "memory");
            const unsigned og = xb_add(&bar[XB_TOP], 1u);
            const unsigned tg = og / nx;
            if (og + 1u == (tg + 1u) * nx) xb_add(&bar[XB_TOPGEN], 1u);
            else XB_SPIN(xb_ld(&bar[XB_TOPGEN]) == tg, bar);
            __builtin_amdgcn_fence(__ATOMIC_ACQUIRE, "agent");
            xb_add(&bar[XB_XGEN(b.x)], 1u);
            asm volatile("s_waitcnt vmcnt(0)" ::: "memory");
        } else {
            XB_SPIN(xb_ld(&bar[XB_XGEN(b.x)]) == gen, bar);
            __builtin_amdgcn_fence(__ATOMIC_ACQUIRE, "agent");
            asm volatile("s_waitcnt vmcnt(0)" ::: "memory");
        }
    }
    __syncthreads();
}


typedef unsigned v2u __attribute__((ext_vector_type(2)));
typedef float f32x2 __attribute__((ext_vector_type(2)));
struct Frame {
    LAS unsigned char* lds;
    volatile LAS unsigned* MISC;
    gu32* ctl;
    int tid, lane, wave;
    int vcu, G;
    const float* in[17];
    float* out;
    unsigned char* ws;
};
__device__ __forceinline__ float bf2f(unsigned short h) { return __builtin_bit_cast(float, (unsigned)h << 16); }
__device__ __forceinline__ float bflo(unsigned w) { return __builtin_bit_cast(float, w << 16); }
__device__ __forceinline__ float bfhi(unsigned w) { return __builtin_bit_cast(float, w & 0xffff0000u); }
__device__ __forceinline__ float sigmoidf_(float x) { return __builtin_amdgcn_rcpf(1.0f + __expf(-x)); }
__device__ __forceinline__ float wave_sum(float v) {
#pragma unroll
    for (int o = 1; o < 64; o <<= 1) v += __shfl_xor(v, o);
    return v;
}
__device__ __forceinline__ f32x4 mfma16(bf16x8 a, bf16x8 b, f32x4 c) { return __builtin_amdgcn_mfma_f32_16x16x32_bf16(a, b, c, 0, 0, 0); }

__device__ __forceinline__ void p0_transpose_item(const float* W, int K, int N, bf16* WT, LAS float* scr, int item, int lane) {
    const int nblk = N / 32, kb = item / nblk, nb = item % nblk, k0 = 128 * kb, n0 = 32 * nb;
    const float* src = W + (size_t)(k0 + (lane >> 3)) * N + n0 + 4 * (lane & 7);
    f32x4 v[16];
#pragma unroll
    for (int i = 0; i < 16; ++i) v[i] = *(const GAS f32x4*)(src + (size_t)(8 * i) * N);
#pragma unroll
    for (int i = 0; i < 16; ++i) { LAS float* d = scr + (8 * i + (lane >> 3)) * 33 + 4 * (lane & 7); d[0] = v[i].x; d[1] = v[i].y; d[2] = v[i].z; d[3] = v[i].w; }
    LDS_WAIT(); asm volatile("" ::: "memory");
    const int c = lane & 15;
#pragma unroll
    for (int j = 0; j < 8; ++j) { const int n = (lane >> 4) + 4 * j; const LAS float* s = scr + (8 * c) * 33 + n;
        v4u o; o.x = pk2(s[0 * 33], s[1 * 33]); o.y = pk2(s[2 * 33], s[3 * 33]); o.z = pk2(s[4 * 33], s[5 * 33]); o.w = pk2(s[6 * 33], s[7 * 33]);
        *(GAS v4u*)(WT + (size_t)(n0 + n) * K + k0 + 8 * c) = o; }
    LDS_WAIT(); asm volatile("" ::: "memory");
}
template <bool GU>
__device__ __forceinline__ void p0_transpose_item_f8(const float* W, int K, int N, unsigned char* WT, LAS float* scr, int item, int lane) {
    const int nblk = N / 32, kb = item / nblk, nb = item % nblk, k0 = 128 * kb, n0 = 32 * nb;
    int d0 = n0;
    if (GU) { const int c = n0 & 1023, up = n0 >> 10; d0 = (c >> 7) * 256 + up * 128 + (c & 127); }
    const float* src = W + (size_t)(k0 + (lane >> 3)) * N + n0 + 4 * (lane & 7);
    f32x4 v[16];
#pragma unroll
    for (int i = 0; i < 16; ++i) v[i] = __builtin_nontemporal_load((const GAS f32x4*)(src + (size_t)(8 * i) * N));
#pragma unroll
    for (int i = 0; i < 16; ++i) { LAS float* d = scr + (8 * i + (lane >> 3)) * 33 + 4 * (lane & 7); d[0] = v[i].x; d[1] = v[i].y; d[2] = v[i].z; d[3] = v[i].w; }
    LDS_WAIT(); asm volatile("" ::: "memory");
    const int c = lane & 15;
    const float S = !GU ? pg8::W8_SCALE : ((n0 >> 10) ? pg8::W8_SCALE / pg8::SWI_C : pg8::W8_SCALE * pg8::SWI_C);
#pragma unroll
    for (int j = 0; j < 8; ++j) { const int n = (lane >> 4) + 4 * j; const LAS float* s = scr + (8 * c) * 33 + n;
        v2u o; o.x = pg8::pk4_fp8(s[0 * 33] * S, s[1 * 33] * S, s[2 * 33] * S, s[3 * 33] * S); o.y = pg8::pk4_fp8(s[4 * 33] * S, s[5 * 33] * S, s[6 * 33] * S, s[7 * 33] * S);
        if (GU) __builtin_nontemporal_store(o, (GAS v2u*)(WT + (size_t)(d0 + n) * K + k0 + 8 * c));
        else *(GAS v2u*)(WT + (size_t)(d0 + n) * K + k0 + 8 * c) = o; }
    LDS_WAIT(); asm volatile("" ::: "memory");
}
__device__ __forceinline__ void conv_item_issue(const float* W, int N, int item, int lane, f32x4 (&v)[16]) {
    const int nblk = N / 32, kb = item / nblk, nb = item % nblk, k0 = 128 * kb, n0 = 32 * nb;
    const float* src = W + (size_t)(k0 + (lane >> 3)) * N + n0 + 4 * (lane & 7);
#pragma unroll
    for (int i = 0; i < 16; ++i) v[i] = __builtin_nontemporal_load((const GAS f32x4*)(src + (size_t)(8 * i) * N));
}
__device__ __forceinline__ void conv_item_finish(int K, int N, unsigned char* WT, LAS float* scr, int item, int lane, const f32x4 (&v)[16]) {
    const int nblk = N / 32, kb = item / nblk, nb = item % nblk, k0 = 128 * kb, n0 = 32 * nb;
#pragma unroll
    for (int i = 0; i < 16; ++i) { LAS float* d = scr + (8 * i + (lane >> 3)) * 33 + 4 * (lane & 7); d[0] = v[i].x; d[1] = v[i].y; d[2] = v[i].z; d[3] = v[i].w; }
    LDS_WAIT(); asm volatile("" ::: "memory");
    const int c = lane & 15;
    constexpr float S = pg8::W8_SCALE;
#pragma unroll
    for (int j = 0; j < 8; ++j) { const int n = (lane >> 4) + 4 * j; const LAS float* s = scr + (8 * c) * 33 + n;
        v2u o; o.x = pg8::pk4_fp8(s[0 * 33] * S, s[1 * 33] * S, s[2 * 33] * S, s[3 * 33] * S); o.y = pg8::pk4_fp8(s[4 * 33] * S, s[5 * 33] * S, s[6 * 33] * S, s[7 * 33] * S);
        *(GAS v2u*)(WT + (size_t)(n0 + n) * K + k0 + 8 * c) = o; }
    LDS_WAIT(); asm volatile("" ::: "memory");
}
__device__ __forceinline__ void rms_row_to_bf16(int lane, const float* xrow, const f32x4 (&gg)[4], bf16* orow) {
    const GAS f32x4* xr = (const GAS f32x4*)xrow + lane;
    f32x4 v[4]; float s = 0.f;
#pragma unroll
    for (int j = 0; j < 4; ++j) { v[j] = xr[64 * j]; s += (v[j].x * v[j].x + v[j].y * v[j].y) + (v[j].z * v[j].z + v[j].w * v[j].w); }
    const float rstd = __builtin_amdgcn_rsqf(wave_sum(s) * (1.f / D) + RMS_EPS);
    GAS unsigned long long* o8 = (GAS unsigned long long*)orow + lane;
#pragma unroll
    for (int j = 0; j < 4; ++j)
        o8[64 * j] = (unsigned long long)pk2(v[j].x * rstd * gg[j].x, v[j].y * rstd * gg[j].y) | ((unsigned long long)pk2(v[j].z * rstd * gg[j].z, v[j].w * rstd * gg[j].w) << 32);
}
__device__ __forceinline__ void p0_prologue(Frame& F) {
    LAS float* scr = (LAS float*)(F.lds + RING_OFF + F.wave * 16896);
    const int gw = F.vcu * NWAVES + F.wave, NGW = F.G * NWAVES;
    bf16* Win_t = (bf16*)(F.ws + WS_WIN); bf16* Wout_t = (bf16*)(F.ws + WS_WOUT);
    constexpr int I_IN = (D / 128) * (INC / 32), I_OUT = (D / 128) * (D / 32);
    for (int it = gw; it < I_IN + I_OUT; it += NGW) {
        if (it < I_IN) p0_transpose_item(F.in[3], D, INC, Win_t, scr, it, F.lane);
        else p0_transpose_item(F.in[8], D, D, Wout_t, scr, it - I_IN, F.lane);
    }
    bf16* XN = (bf16*)(F.ws + WS_XN);
    f32x4 gg[4];
#pragma unroll
    for (int j = 0; j < 4; ++j) gg[j] = ((const GAS f32x4*)F.in[2] + F.lane)[64 * j];
    for (int m = gw; m < M; m += NGW) rms_row_to_bf16(F.lane, F.in[0] + (size_t)m * D, gg, XN + (size_t)m * D);
    { bf16* WrT = (bf16*)(F.ws + WS_WRT); const float* Wr = F.in[10];
      for (int idx = gw * 64 + F.lane; idx < NE * D; idx += NGW * 64) { const int e = idx >> 10, k = idx & 1023; const float w = Wr[k * NE + e];
          const unsigned short hi = (unsigned short)f2bf(w); WrT[idx] = hi; WrT[NE * D + idx] = (unsigned short)f2bf(w - bf2f(hi)); } }
    if (gw >= NGW - NMETA) { const int r = gw - (NGW - NMETA); rms_row_to_bf16(F.lane, F.in[1] + (size_t)r * D, gg, (bf16*)(F.ws + WS_XNM) + (size_t)r * D); }
}
constexpr int CW_CONV = 128, CW_SCAN_DONE = 256;
template <bool PIPE>
__device__ __forceinline__ void p3_convert(Frame& F, int ctr, int part) {
    LAS float* scr = (LAS float*)(F.lds + RING_OFF + F.wave * 16896);
    LAS int* bsh = (LAS int*)(F.lds + TILE_E_OFF + 2048);
    unsigned char* Wgu_t = F.ws + WS_WGU; unsigned char* Wd_t = F.ws + WS_WD;
    constexpr int I_GU = (D / 128) * (2048 / 32), I_DN = (D / 128) * (D / 32);
    const int NITEMS = part == 0 ? NE * I_GU : NE * I_DN;
    for (;;) {
        __syncthreads();
        if (F.tid == 0) bsh[0] = (int)__hip_atomic_fetch_add(F.ctl + CW_CONV + ctr, 64u, RLX_AGENT);
        __syncthreads();
        const int base = bsh[0];
        if (base >= NITEMS) break;
        if constexpr (PIPE) {
            const float* Wd = F.in[14]; f32x4 va[16], vb[16];
            { const int r = base + F.wave; conv_item_issue(Wd + (size_t)(r / I_DN) * D * D, D, r % I_DN, F.lane, va); }
#pragma unroll 1
            for (int ii = 0; ii < 4; ++ii) {
                const int ra = base + (2 * ii) * 8 + F.wave, rbb = ra + 8, rc = ra + 16;
                conv_item_issue(Wd + (size_t)(rbb / I_DN) * D * D, D, rbb % I_DN, F.lane, vb);
                conv_item_finish(D, D, Wd_t + (size_t)(ra / I_DN) * D * D, scr, ra % I_DN, F.lane, va);
                if (ii < 3) conv_item_issue(Wd + (size_t)(rc / I_DN) * D * D, D, rc % I_DN, F.lane, va);
                conv_item_finish(D, D, Wd_t + (size_t)(rbb / I_DN) * D * D, scr, rbb % I_DN, F.lane, vb);
            }
        } else
#pragma unroll 1
        for (int i = 0; i < 8; ++i) {
            const int r = base + i * 8 + F.wave; if (r >= NITEMS) break;
            if (part == 0) { const int e = r / I_GU; p0_transpose_item_f8<true>(F.in[12] + (size_t)e * D * 2048, D, 2048, Wgu_t + (size_t)e * 2048 * D, scr, r % I_GU, F.lane); }
            else { const int e = r / I_DN; p0_transpose_item_f8<false>(F.in[14] + (size_t)e * D * D, D, D, Wd_t + (size_t)e * D * D, scr, r % I_DN, F.lane); }
        }
    }
    __syncthreads();
}

__device__ __forceinline__ void p1_meta_proj(Frame& F) {
    LAS f32x4* part = (LAS f32x4*)(F.lds + RING_OFF);
    const bf16* XNM = (const bf16*)(F.ws + WS_XNM); const bf16* Wt = (const bf16*)(F.ws + WS_WIN); bf16* PM = (bf16*)(F.ws + WS_PROJM);
    const int lane = F.lane, qi = lane & 15, G = lane >> 4, w = F.wave;
    for (int t = blockIdx.x; t < INC / 16; t += F.G) {
        f32x4 acc = {0.f, 0.f, 0.f, 0.f};
        bf16x8 a[4], b[4];
#pragma unroll
        for (int s = 0; s < 4; ++s) { const int k0 = 128 * w + 32 * s + 8 * G;
            a[s] = *(const GAS bf16x8*)(XNM + (size_t)qi * D + k0); b[s] = *(const GAS bf16x8*)(Wt + (size_t)(16 * t + qi) * D + k0); }
#pragma unroll
        for (int s = 0; s < 4; ++s) acc = mfma16(a[s], b[s], acc);
        __syncthreads();
        part[w * 64 + lane] = acc;
        __syncthreads();
        if (w == 0) { f32x4 v = part[lane];
#pragma unroll
            for (int i = 1; i < 8; ++i) v += part[i * 64 + lane];
#pragma unroll
            for (int r = 0; r < 4; ++r) PM[(size_t)(4 * G + r) * INC + 16 * t + qi] = (unsigned short)f2bf(v[r]); }
    }
    __syncthreads();
}

typedef short v4s __attribute__((ext_vector_type(4)));
constexpr int NA_KRING = 0, NA_VRING = 73728, NA_MK = 147456, NA_MV = 149504;
__device__ __forceinline__ v4s na_tr16(const LAS unsigned char* p) { return __builtin_amdgcn_ds_read_tr16_b64_v4i16((LAS v4s*)p); }
__device__ __forceinline__ int na_rs(int r) { const int x = r - 4; return x < 0 ? 0 : (x > 56 ? 56 : x); }
__device__ __forceinline__ void p2_natten(Frame& F) {
    LAS float* rpbL = (LAS float*)(F.lds + NA_MV + 2048);
    static_assert(NA_MV + 2048 + (15 * 31 + 218) * 4 <= LDSCTL_OFF, "NA LDS map");
    static_assert(NWAVES * 64 - (256 + 155) >= 73, "sentinel fill: 73 threads x 3 floats");
    const bf16* P = (const bf16*)(F.ws + WS_R1); const bf16* PM = (const bf16*)(F.ws + WS_PROJM);
    bf16* Y = (bf16*)(F.ws + WS_Y); const float* gna = F.in[5];
    const int lane = F.lane, qi = lane & 15, G = lane >> 4, w = F.wave, tid = F.tid;
    const int skey = tid >> 3, schunk = tid & 7;
    const int sdst = skey * 128 + ((schunk ^ (skey & 7)) << 4);
    const f32x4 z4 = {0.f, 0.f, 0.f, 0.f};
    for (int unit = F.vcu; unit < BATCH * 8 * 8; unit += F.G) {
        const int R = unit & 7, h = (unit >> 3) & 7, b = unit >> 6;
        const bf16* Pk = P + (size_t)(b * SEQ) * INC + C_KA + h * 64 + schunk * 8;
        __syncthreads();
        v4u mreg = {0u, 0u, 0u, 0u}; float r3[3] = {0.f, 0.f, 0.f};
        const int t2 = tid & 127, k2 = t2 >> 3, c2 = t2 & 7;
        if (tid < 256) mreg = *(const GAS v4u*)(PM + (size_t)k2 * INC + (tid < 128 ? C_KA : C_VA) + h * 64 + c2 * 8);
        else if (tid < 256 + 155) { const int i0 = (tid - 256) * 3;
#pragma unroll
            for (int i = 0; i < 3; ++i) r3[i] = F.in[4][h * 465 + i0 + i]; }
        const int g = w & 3, c = 16 * g + qi;
        f32x4 gq[4];
#pragma unroll
        for (int dt = 0; dt < 4; ++dt) gq[dt] = *(const GAS f32x4*)(gna + h * 64 + 16 * dt + 4 * G);
        bf16x8 qf0, qf1;
        { const bf16* qp = P + (size_t)(b * SEQ + (8 * R + (w >> 2)) * 64 + c) * INC + C_QA + h * 64 + 8 * G; qf0 = *(const GAS bf16x8*)(qp); qf1 = *(const GAS bf16x8*)(qp + 32); }
        int hi = na_rs(8 * R + 1) + 7;
        { const int lo = na_rs(8 * R);
          v4u kr[9], vr[9];
#pragma unroll
          for (int i = 0; i < 9; ++i) { const int row = lo + i <= hi ? lo + i : hi; const bf16* src = Pk + (size_t)(row * 64 + skey) * INC; kr[i] = *(const GAS v4u*)(src); vr[i] = *(const GAS v4u*)(src + (C_VA - C_KA)); }
#pragma unroll
          for (int i = 0; i < 9; ++i) { const int row = lo + i <= hi ? lo + i : hi; const int slot = row % 9;
              *(LAS v4u*)(F.lds + NA_KRING + slot * 8192 + sdst) = kr[i]; *(LAS v4u*)(F.lds + NA_VRING + slot * 8192 + sdst) = vr[i]; } }
        if (tid < 256) *(LAS v4u*)(F.lds + (tid < 128 ? NA_MK : NA_MV) + k2 * 128 + ((c2 ^ (k2 & 7)) << 4)) = mreg;
        else if (tid < 256 + 155) { const int i0 = (tid - 256) * 3;
#pragma unroll
            for (int i = 0; i < 3; ++i) rpbL[i0 + i] = r3[i] * 1.44269504089f; }
        else { const int i0 = 465 + (tid - (256 + 155)) * 3;
#pragma unroll
            for (int i = 0; i < 3; ++i) if (i0 + i < 465 + 218) rpbL[i0 + i] = -1e30f; }
        const int cs0 = g == 0 ? 0 : (g == 1 ? 8 : (g == 2 ? 24 : 32));
        int csq = c - 8; csq = csq < 0 ? 0 : (csq > 48 ? 48 : csq);
        const int kofs = (cs0 + qi) * 128, kx = qi & 7;
        const int vkey = cs0 + 4 * G + (qi >> 2), vx = (4 * (G & 1) + (qi >> 2)) & 7, vp = qi & 3;
        __syncthreads();
#pragma unroll 1
        for (int s = 0; s < 4; ++s) {
            const int r0 = 8 * R + 2 * s, r = r0 + (w >> 2), rs = na_rs(r);
            unsigned short warm = 0;
            if (s == 3 && F.vcu < 1024) { const int hu = F.vcu, tt = tid >> 3, arr = (tid >> 1) & 3;
                const int col = (arr == 0 ? C_FF : (arr == 1 ? C_FB : (arr == 2 ? C_QH : C_IH))) + ((hu >> 6) & 3) * 128 + (tid & 1) * 64;
                warm = *(const GAS unsigned short*)(P + (size_t)((hu >> 8) * SEQ + 64 * (hu & 63) + tt) * INC + col); }
            v4u kpre[2], vpre[2]; bf16x8 nq0 = qf0, nq1 = qf1; int nnew = 0;
            if (s < 3) {
                const int nhi = na_rs(r0 + 3) + 7; nnew = nhi - hi;
#pragma unroll
                for (int i = 0; i < 2; ++i) if (i < nnew) { const bf16* src = Pk + (size_t)((hi + 1 + i) * 64 + skey) * INC; kpre[i] = *(const GAS v4u*)(src); vpre[i] = *(const GAS v4u*)(src + (C_VA - C_KA)); }
                const bf16* qp = P + (size_t)(b * SEQ + (r + 2) * 64 + c) * INC + C_QA + h * 64 + 8 * G; nq0 = *(const GAS bf16x8*)(qp); nq1 = *(const GAS bf16x8*)(qp + 32);
            }
            f32x4 st[8][2], sm;
            bf16x8 kc[4], kn[4];
            { const LAS unsigned char* kb = F.lds + NA_KRING + (rs % 9) * 8192 + kofs;
              kc[0] = *(const LAS bf16x8*)(kb + ((G ^ kx) << 4)); kc[1] = *(const LAS bf16x8*)(kb + (((4 + G) ^ kx) << 4));
              kc[2] = *(const LAS bf16x8*)(kb + 2048 + ((G ^ kx) << 4)); kc[3] = *(const LAS bf16x8*)(kb + 2048 + (((4 + G) ^ kx) << 4)); }
#pragma unroll
            for (int i = 0; i < 8; ++i) {
                if (i < 7) { const LAS unsigned char* kb = F.lds + NA_KRING + ((rs + i + 1) % 9) * 8192 + kofs;
                    kn[0] = *(const LAS bf16x8*)(kb + ((G ^ kx) << 4)); kn[1] = *(const LAS bf16x8*)(kb + (((4 + G) ^ kx) << 4));
                    kn[2] = *(const LAS bf16x8*)(kb + 2048 + ((G ^ kx) << 4)); kn[3] = *(const LAS bf16x8*)(kb + 2048 + (((4 + G) ^ kx) << 4)); }
                else { const LAS unsigned char* kb = F.lds + NA_MK + qi * 128;
                    kn[0] = *(const LAS bf16x8*)(kb + ((G ^ kx) << 4)); kn[1] = *(const LAS bf16x8*)(kb + (((4 + G) ^ kx) << 4)); kn[2] = kn[0]; kn[3] = kn[1]; }
                st[i][0] = mfma16(kc[0], qf0, z4); st[i][1] = mfma16(kc[2], qf0, z4);
                st[i][0] = mfma16(kc[1], qf1, st[i][0]); st[i][1] = mfma16(kc[3], qf1, st[i][1]);
#pragma unroll
                for (int q = 0; q < 4; ++q) kc[q] = kn[q];
            }
            sm = mfma16(kc[0], qf0, z4); sm = mfma16(kc[1], qf1, sm);
            float mx = -1e30f;
#pragma unroll
            for (int n = 0; n < 2; ++n)
#pragma unroll
                for (int j = 0; j < 4; ++j) {
                    const int cc = cs0 + 16 * n + 4 * G + j; const bool valid = (cc >= csq) && (cc < csq + 16); const int dc = cc - c + 15;
                    const LAS float* bp = rpbL + (valid ? (rs - r + 7) * 31 + dc : 465);
                    float bv[8];
#pragma unroll
                    for (int i = 0; i < 8; ++i) bv[i] = bp[i * 31];
#pragma unroll
                    for (int i = 0; i < 8; ++i) { const float sv = st[i][n][j] * (0.125f * 1.44269504089f) + bv[i]; st[i][n][j] = sv; mx = fmaxf(mx, sv); }
                }
#pragma unroll
            for (int j = 0; j < 4; ++j) { sm[j] *= 0.125f * 1.44269504089f; mx = fmaxf(mx, sm[j]); }
            mx = fmaxf(mx, __shfl_xor(mx, 16)); mx = fmaxf(mx, __shfl_xor(mx, 32));
            float sum = 0.f;
#pragma unroll
            for (int i = 0; i < 8; ++i)
#pragma unroll
                for (int n = 0; n < 2; ++n)
#pragma unroll
                    for (int j = 0; j < 4; ++j) { const float p = __builtin_amdgcn_exp2f(st[i][n][j] - mx); st[i][n][j] = p; sum += p; }
#pragma unroll
            for (int j = 0; j < 4; ++j) { const float p = __builtin_amdgcn_exp2f(sm[j] - mx); sm[j] = p; sum += p; }
            sum += __shfl_xor(sum, 16); sum += __shfl_xor(sum, 32);
            f32x4 o[4] = {z4, z4, z4, z4};
            bf16x8 vc[4], vn[4];
            { const LAS unsigned char* vb = F.lds + NA_VRING + (rs % 9) * 8192 + vkey * 128 + 8 * (vp & 1);
#pragma unroll
              for (int dt = 0; dt < 4; ++dt) { const int co = ((2 * dt + (vp >> 1)) ^ vx) << 4; const v4s lo = na_tr16(vb + co), hi4 = na_tr16(vb + 2048 + co);
                  vc[dt] = (bf16x8){lo[0], lo[1], lo[2], lo[3], hi4[0], hi4[1], hi4[2], hi4[3]}; } }
#pragma unroll
            for (int i = 0; i < 8; ++i) {
                if (i < 7) { const LAS unsigned char* vb = F.lds + NA_VRING + ((rs + i + 1) % 9) * 8192 + vkey * 128 + 8 * (vp & 1);
#pragma unroll
                    for (int dt = 0; dt < 4; ++dt) { const int co = ((2 * dt + (vp >> 1)) ^ vx) << 4; const v4s lo = na_tr16(vb + co), hi4 = na_tr16(vb + 2048 + co);
                        vn[dt] = (bf16x8){lo[0], lo[1], lo[2], lo[3], hi4[0], hi4[1], hi4[2], hi4[3]}; } }
                else { const int mkey = 4 * G + (qi >> 2); const LAS unsigned char* vb = F.lds + NA_MV + mkey * 128 + 8 * (vp & 1);
#pragma unroll
                    for (int dt = 0; dt < 4; ++dt) { const v4s lo = na_tr16(vb + (((2 * dt + (vp >> 1)) ^ (mkey & 7)) << 4)); vn[dt] = (bf16x8){lo[0], lo[1], lo[2], lo[3], 0, 0, 0, 0}; } }
                bf16x8 pf; { v4u wv; wv.x = pk2(st[i][0][0], st[i][0][1]); wv.y = pk2(st[i][0][2], st[i][0][3]); wv.z = pk2(st[i][1][0], st[i][1][1]); wv.w = pk2(st[i][1][2], st[i][1][3]); pf = __builtin_bit_cast(bf16x8, wv); }
#pragma unroll
                for (int dt = 0; dt < 4; ++dt) o[dt] = mfma16(vc[dt], pf, o[dt]);
#pragma unroll
                for (int dt = 0; dt < 4; ++dt) vc[dt] = vn[dt];
            }
            { bf16x8 pf; { v4u wv; wv.x = pk2(sm[0], sm[1]); wv.y = pk2(sm[2], sm[3]); wv.z = 0u; wv.w = 0u; pf = __builtin_bit_cast(bf16x8, wv); }
#pragma unroll
              for (int dt = 0; dt < 4; ++dt) o[dt] = mfma16(vc[dt], pf, o[dt]); }
            const float inv = __builtin_amdgcn_rcpf(sum); float q2 = 0.f;
#pragma unroll
            for (int dt = 0; dt < 4; ++dt)
#pragma unroll
                for (int j = 0; j < 4; ++j) q2 += o[dt][j] * o[dt][j];
            q2 += __shfl_xor(q2, 16); q2 += __shfl_xor(q2, 32);
            const float rn = inv * __builtin_amdgcn_rsqf(q2 * (inv * inv) * (1.0f / 64.0f) + RMS_EPS);
            bf16* yp = Y + (size_t)(b * SEQ + r * 64 + c) * D + h * 64 + 4 * G;
#pragma unroll
            for (int dt = 0; dt < 4; ++dt) { const f32x4 gg = gq[dt];
                v2u wv; wv.x = pk2(o[dt][0] * rn * gg.x, o[dt][1] * rn * gg.y); wv.y = pk2(o[dt][2] * rn * gg.z, o[dt][3] * rn * gg.w);
                *(GAS v2u*)(yp + 16 * dt) = wv; }
            asm volatile("" :: "v"(warm));
            __syncthreads();
            if (s < 3) {
#pragma unroll
                for (int i = 0; i < 2; ++i) if (i < nnew) { const int slot = (hi + 1 + i) % 9;
                    *(LAS v4u*)(F.lds + NA_KRING + slot * 8192 + sdst) = kpre[i]; *(LAS v4u*)(F.lds + NA_VRING + slot * 8192 + sdst) = vpre[i]; }
                hi += nnew; qf0 = nq0; qf1 = nq1;
            }
            __syncthreads();
        }
    }
    __syncthreads();
}

constexpr int HP_PK = 72, HP_PX = 24;
constexpr int HP_QS = 0, HP_KD = 18432, HP_KE = 36864, HP_QT = 55296, HP_QX = 73728, HP_HA = 92160, HP_TS = 101376;
typedef unsigned short us16 __attribute__((ext_vector_type(16)));
__device__ __forceinline__ unsigned cvtpk(float lo, float hi) { typedef float f2_t __attribute__((ext_vector_type(2))); typedef __bf16 b2_t __attribute__((ext_vector_type(2))); f2_t v = {lo, hi}; b2_t b = __builtin_convertvector(v, b2_t); return __builtin_bit_cast(unsigned, b); }
template <bool REV> __device__ __forceinline__ void pack16(const float (&x)[16], v4u& a, v4u& b) {
    if (!REV) { a.x = cvtpk(x[0], x[1]); a.y = cvtpk(x[2], x[3]); a.z = cvtpk(x[4], x[5]); a.w = cvtpk(x[6], x[7]); b.x = cvtpk(x[8], x[9]); b.y = cvtpk(x[10], x[11]); b.z = cvtpk(x[12], x[13]); b.w = cvtpk(x[14], x[15]); }
    else { a.x = cvtpk(x[15], x[14]); a.y = cvtpk(x[13], x[12]); a.z = cvtpk(x[11], x[10]); a.w = cvtpk(x[9], x[8]); b.x = cvtpk(x[7], x[6]); b.y = cvtpk(x[5], x[4]); b.z = cvtpk(x[3], x[2]); b.w = cvtpk(x[1], x[0]); }
}
template <bool REV>
__device__ __forceinline__ void hprep_dir_a(Frame& F, const float (&gl)[16], const float (&kk)[16], const float (&qq)[16], const unsigned short (&vv)[16], int dslot,
                                            bf16* HK, bf16* HV, float* HDp) {
    LAS unsigned char* L = F.lds + RING_OFF;
    LAS float* Tsh = (LAS float*)(L + HP_TS) + dslot * 512;
    const int k = F.tid & 127, i = F.tid >> 7, ic = REV ? 3 - i : i;
    float bl[16];
    if (!REV) { float run = 1.f;
#pragma unroll
        for (int tt = 0; tt < 16; ++tt) { run *= gl[tt]; bl[tt] = run; } }
    else { float run = 1.f;
#pragma unroll
        for (int tt = 15; tt >= 0; --tt) { run *= gl[tt]; bl[tt] = run; } }
    const float Ti = REV ? bl[0] : bl[15];
    Tsh[ic * 128 + k] = Ti;
    __syncthreads();
    const float T0 = Tsh[k], T1 = Tsh[128 + k], T2 = Tsh[256 + k], T3 = Tsh[384 + k];
    const float eE = ic == 0 ? 1.f : (ic == 1 ? T0 : (ic == 2 ? T0 * T1 : T0 * T1 * T2));
    const float eA = ic == 0 ? T1 * T2 * T3 : (ic == 1 ? T2 * T3 : (ic == 2 ? T3 : 1.f));
    const float eT = Ti;
    const float x0 = ic == 2 ? T1 : T2, x1 = T1 * T2;
    float qs[16], kd[16], ke[16], qt[16], kh[16];
    float su[16];
    if (!REV) { float run = 1.f;
#pragma unroll
        for (int tt = 15; tt >= 0; --tt) { su[tt] = run; run *= gl[tt]; } }
    else { float run = 1.f;
#pragma unroll
        for (int tt = 0; tt < 16; ++tt) { su[tt] = run; run *= gl[tt]; } }
    const float rT = __builtin_amdgcn_rcpf(eT);
#pragma unroll
    for (int tt = 0; tt < 16; ++tt) { const float eb = bl[tt];
        qs[tt] = qq[tt] * eb; ke[tt] = kk[tt] * su[tt]; kd[tt] = ke[tt] * rT; qt[tt] = qs[tt] * eE; kh[tt] = ke[tt] * eA; }
    v4u a, b2;
    const int ro = k * (HP_PK * 2) + ic * 32;
    pack16<REV>(qs, a, b2); *(LAS v4u*)(L + HP_QS + ro) = a; *(LAS v4u*)(L + HP_QS + ro + 16) = b2;
    pack16<REV>(kd, a, b2); *(LAS v4u*)(L + HP_KD + ro) = a; *(LAS v4u*)(L + HP_KD + ro + 16) = b2;
    pack16<REV>(ke, a, b2); *(LAS v4u*)(L + HP_KE + ro) = a; *(LAS v4u*)(L + HP_KE + ro + 16) = b2;
    pack16<REV>(qt, a, b2); *(LAS v4u*)(L + HP_QT + ro) = a; *(LAS v4u*)(L + HP_QT + ro + 16) = b2;
    if (ic >= 2) { float t0[16];
#pragma unroll
        for (int tt = 0; tt < 16; ++tt) t0[tt] = qs[tt] * x0;
        pack16<REV>(t0, a, b2); const int xo = HP_QX + (ic == 2 ? 0 : 1) * (128 * HP_PX * 2) + k * (HP_PX * 2); *(LAS v4u*)(L + xo) = a; *(LAS v4u*)(L + xo + 16) = b2;
        if (ic == 3) {
#pragma unroll
            for (int tt = 0; tt < 16; ++tt) t0[tt] = qs[tt] * x1;
            pack16<REV>(t0, a, b2); const int xo2 = HP_QX + 2 * (128 * HP_PX * 2) + k * (HP_PX * 2); *(LAS v4u*)(L + xo2) = a; *(LAS v4u*)(L + xo2 + 16) = b2; } }
    pack16<REV>(kh, a, b2);
    { bf16* p = HK + ((((k >> 4) * 2 + (ic >> 1)) * 64) + 32 * (ic & 1) + (k & 15)) * 8; *(GAS v4u*)p = a; *(GAS v4u*)(p + 128) = b2; }
    { v4u c, d;
      if (!REV) { c.x = vv[0] | ((unsigned)vv[1] << 16); c.y = vv[2] | ((unsigned)vv[3] << 16); c.z = vv[4] | ((unsigned)vv[5] << 16); c.w = vv[6] | ((unsigned)vv[7] << 16);
                  d.x = vv[8] | ((unsigned)vv[9] << 16); d.y = vv[10] | ((unsigned)vv[11] << 16); d.z = vv[12] | ((unsigned)vv[13] << 16); d.w = vv[14] | ((unsigned)vv[15] << 16); }
      else { c.x = vv[15] | ((unsigned)vv[14] << 16); c.y = vv[13] | ((unsigned)vv[12] << 16); c.z = vv[11] | ((unsigned)vv[10] << 16); c.w = vv[9] | ((unsigned)vv[8] << 16);
             d.x = vv[7] | ((unsigned)vv[6] << 16); d.y = vv[5] | ((unsigned)vv[4] << 16); d.z = vv[3] | ((unsigned)vv[2] << 16); d.w = vv[1] | ((unsigned)vv[0] << 16); }
      bf16* p = HV + ((((k >> 4) * 2 + (ic >> 1)) * 64) + 32 * (ic & 1) + (k & 15)) * 8; *(GAS v4u*)p = c; *(GAS v4u*)(p + 128) = d; }
    if (i == 0) HDp[k] = (T0 * T1) * (T2 * T3);
    __syncthreads();
}
__device__ __forceinline__ void hprep_dir_b(Frame& F, bf16* HQ, bf16* HA) {
    LAS unsigned char* L = F.lds + RING_OFF;
    const int lane = F.lane, qi = lane & 15, G = lane >> 4, w = F.wave;
#pragma unroll
    for (int f = 0; f < 2; ++f) { const int fw = (2 * w + f) >> 2, fs = (2 * w + f) & 3;
        const LAS unsigned char* p = L + HP_QT + (32 * fs + 4 * G + (qi >> 2)) * (HP_PK * 2) + (16 * fw + 4 * (qi & 3)) * 2;
        const v4s lo = na_tr16(p), hi = na_tr16(p + 16 * (HP_PK * 2));
        v4u o; o.x = (unsigned short)lo[0] | ((unsigned)(unsigned short)lo[1] << 16); o.y = (unsigned short)lo[2] | ((unsigned)(unsigned short)lo[3] << 16);
        o.z = (unsigned short)hi[0] | ((unsigned)(unsigned short)hi[1] << 16); o.w = (unsigned short)hi[2] | ((unsigned)(unsigned short)hi[3] << 16);
        *(GAS v4u*)(HQ + ((2 * w + f) * 64 + lane) * 8) = o; }
    for (int job = w; job < 16; job += NWAVES) {
        int ti, sj, qsel;
        switch (job) { case 0: ti = 0; sj = 0; qsel = 0; break; case 1: ti = 1; sj = 1; qsel = 0; break; case 2: ti = 2; sj = 2; qsel = 0; break; case 3: ti = 3; sj = 3; qsel = 0; break;
                       case 4: ti = 1; sj = 0; qsel = 0; break; case 5: ti = 2; sj = 1; qsel = 0; break; case 6: ti = 3; sj = 2; qsel = 0; break;
                       case 7: ti = 2; sj = 0; qsel = 1; break; case 8: ti = 3; sj = 1; qsel = 2; break; case 9: ti = 3; sj = 0; qsel = 3; break;
                       case 10: ti = 0; sj = 1; qsel = -1; break; case 11: ti = 0; sj = 2; qsel = -1; break; case 12: ti = 0; sj = 3; qsel = -1; break;
                       case 13: ti = 1; sj = 2; qsel = -1; break; case 14: ti = 1; sj = 3; qsel = -1; break; default: ti = 2; sj = 3; qsel = -1; break; }
        f32x4 acc = {0.f, 0.f, 0.f, 0.f};
        if (qsel >= 0) {
            const LAS unsigned char* ap = qsel == 0 ? L + HP_QS + (8 * G + (qi >> 2)) * (HP_PK * 2) + (16 * ti + 4 * (qi & 3)) * 2
                                                    : L + HP_QX + (qsel - 1) * (128 * HP_PX * 2) + (8 * G + (qi >> 2)) * (HP_PX * 2) + (4 * (qi & 3)) * 2;
            const int apitch = qsel == 0 ? HP_PK * 2 : HP_PX * 2;
            const LAS unsigned char* bp = L + (ti == sj ? HP_KD : HP_KE) + (8 * G + (qi >> 2)) * (HP_PK * 2) + (16 * sj + 4 * (qi & 3)) * 2;
#pragma unroll
            for (int ks = 0; ks < 4; ++ks) {
                const v4s a0 = na_tr16(ap + (32 * ks) * apitch), a1 = na_tr16(ap + (32 * ks + 4) * apitch);
                const v4s b0 = na_tr16(bp + (32 * ks) * (HP_PK * 2)), b1 = na_tr16(bp + (32 * ks + 4) * (HP_PK * 2));
                const bf16x8 af = {a0[0], a0[1], a0[2], a0[3], a1[0], a1[1], a1[2], a1[3]}, bf = {b0[0], b0[1], b0[2], b0[3], b1[0], b1[1], b1[2], b1[3]};
                acc = mfma16(af, bf, acc); }
        }
        LAS bf16* im = (LAS bf16*)(L + HP_HA);
#pragma unroll
        for (int r = 0; r < 4; ++r) { float v = acc[r]; if (ti == sj && qi > 4 * G + r) v = 0.f;
            im[(16 * ti + 4 * G + r) * HP_PK + 16 * sj + qi] = (unsigned short)(cvtpk(v, v) & 0xffffu); }
    }
    __syncthreads();
    { const v4u o = *(const LAS v4u*)(L + HP_HA + (16 * (w >> 1) + qi) * (HP_PK * 2) + (32 * (w & 1) + 8 * G) * 2); *(GAS v4u*)(HA + (w * 64 + lane) * 8) = o; }
    __syncthreads();
}
template <bool REV>
__device__ __forceinline__ void hprep_dir(Frame& F, const float (&gl)[16], const float (&kk)[16], const float (&qq)[16], const unsigned short (&vv)[16], int dslot,
                                          bf16* HQ, bf16* HK, bf16* HV, bf16* HA, float* HDp) {
    hprep_dir_a<REV>(F, gl, kk, qq, vv, dslot, HK, HV, HDp); hprep_dir_b(F, HQ, HA);
}
__device__ __forceinline__ void hprep_unit(Frame& F, bool meta, int b, int h, int j, unsigned char* r2, size_t u0, unsigned char* mb0, int mdir = 0) {
    const bf16* P = (const bf16*)(F.ws + WS_R1); const bf16* PM = (const bf16*)(F.ws + WS_PROJM);
    const int k = F.tid & 127, i = F.tid >> 7;
    const float* lbl = F.in[6] + h * 128 + k;
    const float lbf = sigmoidf_(lbl[0] - lbl[512]), lbb = sigmoidf_(lbl[1024] - lbl[1536]);
    float gf[16], kf[16], gb[16], kb[16], qq[16]; unsigned short vv[16];
    const bool ok = !meta || i == 0;
    unsigned short rxf[16], rxb[16], rqv[16];
#pragma unroll
    for (int tt = 0; tt < 16; ++tt) {
        const bf16* rp = meta ? PM + (size_t)tt * INC : P + (size_t)(b * SEQ + 64 * j + 16 * i + tt) * INC;
        rxf[tt] = rp[C_FF + h * 128 + k]; rxb[tt] = rp[C_FB + h * 128 + k]; rqv[tt] = rp[C_QH + h * 128 + k]; vv[tt] = rp[C_IH + h * 128 + k];
    }
    __builtin_amdgcn_sched_barrier(0);
#pragma unroll
    for (int tt = 0; tt < 16; ++tt) {
        const float lb1 = meta ? (mdir ? lbb : lbf) : lbf;
        const float xf = bf2f(meta ? (mdir ? rxb[tt] : rxf[tt]) : rxf[tt]), qv = bf2f(rqv[tt]);
        const float ef = __expf(-xf), sf = __builtin_amdgcn_rcpf(1.0f + ef), eq = __expf(-qv), sq = __builtin_amdgcn_rcpf(1.0f + eq);
        const float tf = (1.0f - lb1) * sf;
        gf[tt] = ok ? lb1 + tf : 1.0f; kf[tt] = ok ? (1.0f - lb1) - tf : 0.f;
        if (!meta) { const float xb = bf2f(rxb[tt]); const float eb = __expf(-xb), sb = __builtin_amdgcn_rcpf(1.0f + eb); const float tb = (1.0f - lbb) * sb;
            gb[tt] = lbb + tb; kb[tt] = (1.0f - lbb) - tb; }
        else { gb[tt] = 1.0f; kb[tt] = 0.f; }
        qq[tt] = ok ? qv * sq : 0.f; vv[tt] = ok ? vv[tt] : (unsigned short)0;
    }
    if (!meta) {
        hprep_dir<false>(F, gf, kf, qq, vv, 0, (bf16*)(r2 + R2_HQ) + u0 * HU_Q, (bf16*)(r2 + R2_HK) + u0 * HU_K, (bf16*)(r2 + R2_HV) + u0 * HU_V, (bf16*)(r2 + R2_HA) + u0 * HU_A, (float*)(r2 + R2_HD) + u0 * HU_D);
        hprep_dir<true>(F, gb, kb, qq, vv, 1, (bf16*)(r2 + R2_HQ) + (u0 + 1) * HU_Q, (bf16*)(r2 + R2_HK) + (u0 + 1) * HU_K, (bf16*)(r2 + R2_HV) + (u0 + 1) * HU_V, (bf16*)(r2 + R2_HA) + (u0 + 1) * HU_A, (float*)(r2 + R2_HD) + (u0 + 1) * HU_D);
    } else {
        unsigned char* mb = mb0 + (size_t)mdir * 65536;
        hprep_dir<false>(F, gf, kf, qq, vv, mdir, (bf16*)(mb + 49152), (bf16*)(mb), (bf16*)(mb + 16384), (bf16*)(mb + 32768), (float*)(mb + 40960));
    }
}
struct HRaw { unsigned short xf[16], xb[16], qv[16]; };
__device__ __forceinline__ void hprep_load(Frame& F, int b, int h, int j, HRaw& r) {
    const bf16* P = (const bf16*)(F.ws + WS_R1); const int k = F.tid & 127, i = F.tid >> 7;
#pragma unroll
    for (int tt = 0; tt < 16; ++tt) { const bf16* rp = P + (size_t)(b * SEQ + 64 * j + 16 * i + tt) * INC;
        r.xf[tt] = rp[C_FF + h * 128 + k]; r.xb[tt] = rp[C_FB + h * 128 + k]; r.qv[tt] = rp[C_QH + h * 128 + k]; }
}
__device__ __forceinline__ void hprep_unit_reg(Frame& F, float lbf, float lbb, unsigned char* r2, size_t u0, int b, int h, int j, const HRaw& cur, bool has_next, int nb, int nh, int nj, HRaw& nxt) {
    float gf[16], kf[16], qq[16]; unsigned short vv[16];
    { const bf16* P = (const bf16*)(F.ws + WS_R1); const int k = F.tid & 127, i = F.tid >> 7;
#pragma unroll
      for (int tt = 0; tt < 16; ++tt) vv[tt] = P[(size_t)(b * SEQ + 64 * j + 16 * i + tt) * INC + C_IH + h * 128 + k]; }
#pragma unroll
    for (int tt = 0; tt < 16; ++tt) {
        const float xf = bf2f(cur.xf[tt]), qv = bf2f(cur.qv[tt]);
        const float ef = __expf(-xf), sf = __builtin_amdgcn_rcpf(1.0f + ef), eq = __expf(-qv), sq = __builtin_amdgcn_rcpf(1.0f + eq);
        const float tf = (1.0f - lbf) * sf;
        gf[tt] = lbf + tf; kf[tt] = (1.0f - lbf) - tf; qq[tt] = qv * sq;
    }
    hprep_dir<false>(F, gf, kf, qq, vv, 0, (bf16*)(r2 + R2_HQ) + u0 * HU_Q, (bf16*)(r2 + R2_HK) + u0 * HU_K, (bf16*)(r2 + R2_HV) + u0 * HU_V, (bf16*)(r2 + R2_HA) + u0 * HU_A, (float*)(r2 + R2_HD) + u0 * HU_D);
    __builtin_amdgcn_sched_barrier(0);
#pragma unroll
    for (int tt = 0; tt < 16; ++tt) { const float xb = bf2f(cur.xb[tt]); const float eb = __expf(-xb), sb = __builtin_amdgcn_rcpf(1.0f + eb); const float tb = (1.0f - lbb) * sb;
        gf[tt] = lbb + tb; kf[tt] = (1.0f - lbb) - tb; }
    hprep_dir_a<true>(F, gf, kf, qq, vv, 1, (bf16*)(r2 + R2_HK) + (u0 + 1) * HU_K, (bf16*)(r2 + R2_HV) + (u0 + 1) * HU_V, (float*)(r2 + R2_HD) + (u0 + 1) * HU_D);
    __builtin_amdgcn_sched_barrier(0);
    if (has_next) hprep_load(F, nb, nh, nj, nxt);
    hprep_dir_b(F, (bf16*)(r2 + R2_HQ) + (u0 + 1) * HU_Q, (bf16*)(r2 + R2_HA) + (u0 + 1) * HU_A);
}
__device__ __forceinline__ void p2_hprep(Frame& F) {
    unsigned char* r2 = F.ws + WS_R2;
    int u = F.vcu;
    if (u < 1024) {
        const int k = F.tid & 127;
        HRaw cur; { const int j = u & 63, h = (u >> 6) & 3, b = u >> 8; hprep_load(F, b, h, j, cur); }
        int hprev = -1; float lbf = 0.f, lbb = 0.f;
#pragma unroll 1
        for (; u < 1024; u += F.G) {
            const int j = u & 63, h = (u >> 6) & 3, b = u >> 8;
            if (h != hprev) { const float* lbl = F.in[6] + h * 128 + k; lbf = sigmoidf_(lbl[0] - lbl[512]); lbb = sigmoidf_(lbl[1024] - lbl[1536]); hprev = h; }
            const int un = u + F.G; const bool hn = un < 1024; const int nu = hn ? un : u;
            HRaw nxt;
            hprep_unit_reg(F, lbf, lbb, r2, (size_t)u * 2, b, h, j, cur, hn, nu >> 8, (nu >> 6) & 3, nu & 63, nxt);
            if (hn) cur = nxt;
        }
    }
    for (; u < 1024 + 8; u += F.G) { const int h = (u - 1024) >> 1; hprep_unit(F, true, 0, h, 0, r2, 0, r2 + R2_META + (size_t)(h * 2) * 65536, (u - 1024) & 1); }
}

#ifndef HS_WARM
#define HS_WARM 0
#endif
struct HSOps { bf16x8 qf[4], af[2], kf[2][2]; };
constexpr int HS_SBUF = 0, HS_OBUF = 16384, HS_DUMMY = 32768, HS_RING = 36864, HS_STAGE = 5120;
__device__ __forceinline__ void ld16(bf16x8& r, const void* p) { asm volatile("global_load_dwordx4 %0, %1, off" : "=v"(r) : "v"(p) : "memory"); }
struct HSPtr { const unsigned char *HQ, *HK, *HV, *HA, *HD; };
__device__ __forceinline__ HSPtr hseq_ptrs(unsigned char* r2, int c, int b, int h, int dir) {
    c = c > 64 ? 64 : (c < 0 ? 0 : c);
    HSPtr p;
    if (c == 0) { const int mu = h * 2 + dir; const unsigned char* mb = r2 + R2_META + (size_t)mu * 65536; p.HK = mb; p.HV = mb + 16384; p.HA = mb + 32768; p.HD = mb + 40960; p.HQ = mb + 49152; }
    else { const int j = dir ? 64 - c : c - 1; const size_t u = (size_t)(((b * 4 + h) * 64 + j) * 2 + dir);
        p.HQ = r2 + R2_HQ + u * HU_Q * 2; p.HK = r2 + R2_HK + u * HU_K * 2; p.HV = r2 + R2_HV + u * HU_V * 2; p.HA = r2 + R2_HA + u * HU_A * 2; p.HD = r2 + R2_HD + u * HU_D * 4; }
    return p;
}
__device__ __forceinline__ void hseq_load(HSOps& L, unsigned char* r2, int c, int b, int h, int dir, int w, int lane) {
    const HSPtr p = hseq_ptrs(r2, c, b, h, dir);
#pragma unroll
    for (int s = 0; s < 4; ++s) ld16(L.qf[s], p.HQ + ((w * 4 + s) * 64 + lane) * 16);
#pragma unroll
    for (int ks = 0; ks < 2; ++ks) { ld16(L.af[ks], p.HA + ((w * 2 + ks) * 64 + lane) * 16);
#pragma unroll
        for (int i = 0; i < 2; ++i) ld16(L.kf[i][ks], p.HK + (((w * 2 + i) * 2 + ks) * 64 + lane) * 16); }
}
#define HSEQ_WAIT(L) asm volatile("s_waitcnt vmcnt(30)" : "+v"(L.qf[0]), "+v"(L.qf[1]), "+v"(L.qf[2]), "+v"(L.qf[3]), "+v"(L.af[0]), "+v"(L.af[1]), "+v"(L.kf[0][0]), "+v"(L.kf[0][1]), "+v"(L.kf[1][0]), "+v"(L.kf[1][1]) :: "memory")
#define HSEQ_BAR() do { asm volatile("s_waitcnt lgkmcnt(0)" ::: "memory"); __builtin_amdgcn_s_barrier(); asm volatile("" ::: "memory"); } while (0)
__device__ __forceinline__ void hseq_step(HSOps& L, f32x4 (&st)[2][2], LAS unsigned char* lds, int c, int w, int lane, int qi, int G) {
    LAS v4u* sbuf = (LAS v4u*)(lds + HS_SBUF); LAS float* obuf = (LAS float*)(lds + HS_OBUF);
#pragma unroll
    for (int nt = 0; nt < 2; ++nt) { v4u sw; sw.x = pk2(st[0][nt][0], st[0][nt][1]); sw.y = pk2(st[0][nt][2], st[0][nt][3]); sw.z = pk2(st[1][nt][0], st[1][nt][1]); sw.w = pk2(st[1][nt][2], st[1][nt][3]);
        sbuf[(((c & 1) * 4 + w) * 2 + nt) * 64 + lane] = sw; }
    HSEQ_BAR();
    HSEQ_WAIT(L);
    const LAS unsigned char* rg = lds + HS_RING + (c & 3) * HS_STAGE;
    bf16x8 vf[2][2]; f32x4 dv[2];
#pragma unroll
    for (int nt = 0; nt < 2; ++nt)
#pragma unroll
        for (int ks = 0; ks < 2; ++ks) vf[nt][ks] = *(const LAS bf16x8*)(rg + ((nt * 2 + ks) * 64 + lane) * 16);
#pragma unroll
    for (int i = 0; i < 2; ++i) dv[i] = *(const LAS f32x4*)(rg + 4096 + (32 * w + 16 * i + 4 * G) * 4);
    f32x4 o[2] = {{0.f, 0.f, 0.f, 0.f}, {0.f, 0.f, 0.f, 0.f}};
#pragma unroll
    for (int s = 0; s < 4; ++s)
#pragma unroll
        for (int nt = 0; nt < 2; ++nt) { const v4u sb = sbuf[(((c & 1) * 4 + s) * 2 + nt) * 64 + lane]; o[nt] = mfma16(L.qf[s], __builtin_bit_cast(bf16x8, sb), o[nt]); }
#pragma unroll
    for (int ks = 0; ks < 2; ++ks)
#pragma unroll
        for (int nt = 0; nt < 2; ++nt) o[nt] = mfma16(L.af[ks], vf[nt][ks], o[nt]);
#pragma unroll
    for (int i = 0; i < 2; ++i)
#pragma unroll
        for (int nt = 0; nt < 2; ++nt) { st[i][nt] = st[i][nt] * dv[i];
#pragma unroll
            for (int ks = 0; ks < 2; ++ks) st[i][nt] = mfma16(L.kf[i][ks], vf[nt][ks], st[i][nt]); }
    LAS float* ob = obuf + ((c & 1) * 4 + w) * 512;
#pragma unroll
    for (int nt = 0; nt < 2; ++nt)
#pragma unroll
        for (int r = 0; r < 4; ++r) ob[(4 * G + r) * 32 + 16 * nt + qi] = o[nt][r];
}
__device__ __forceinline__ void hseq_helper(unsigned char* r2, bf16* Od, float* dummy, LAS unsigned char* lds, int c, int PD, int b, int h, int dir, int vp, int hw, int lane) {
    { const HSPtr p = hseq_ptrs(r2, c + 3, b, h, dir); LAS unsigned char* rg = lds + HS_RING + ((c + 3) & 3) * HS_STAGE;
      __builtin_amdgcn_global_load_lds((const unsigned*)(p.HV + (size_t)vp * 4096 + hw * 1024 + lane * 16), (LAS unsigned*)(rg + hw * 1024), 16, 0, 0);
      if (hw == 0) __builtin_amdgcn_global_load_lds((const unsigned*)(p.HD + lane * 16), (LAS unsigned*)(rg + 4096), 16, 0, 0); }
    { const int cs = c - 1; const bool real = cs >= 1 && cs <= 64; const int j = dir ? 64 - cs : cs - 1;
      const LAS float* ob = (const LAS float*)(lds + HS_OBUF) + ((cs & 1) * 4 + hw) * 512;
#pragma unroll
      for (int i = 0; i < 2; ++i) { const int row = 8 * i + (lane >> 3), tc = 16 * hw + row, tk = dir ? 63 - tc : tc;
          const f32x4 v = *(const LAS f32x4*)(ob + row * 32 + 4 * (lane & 7));
          bf16* dst = real ? Od + (size_t)(b * SEQ + 64 * j + tk) * 512 + h * 128 + 32 * vp + 4 * (lane & 7) : (bf16*)dummy + (i * 64 + lane) * 4;
          v2u pk; pk.x = cvtpk(v.x, v.y); pk.y = cvtpk(v.z, v.w); *(GAS v2u*)dst = pk; } }
#if HS_WARM
    { const HSPtr p = hseq_ptrs(r2, c + PD, b, h, dir); LAS unsigned* slot = (LAS unsigned*)(lds + HS_DUMMY + hw * 1024);
#pragma unroll
      for (int i = 0; i < 3; ++i) { const int q = 10 * vp + hw + 4 * i;
          if (i < 2 || hw < 2) { const unsigned char* s = q < 16 ? p.HQ + q * 1024 : (q < 32 ? p.HK + (q - 16) * 1024 : p.HA + (q - 32) * 1024);
              __builtin_amdgcn_global_load_lds((const unsigned*)(s + lane * 16), slot, 16, 0, 0); } } }
#endif
}
__device__ __forceinline__ void p3_hseq(Frame& F) {
    const int blk = blockIdx.x;
    if (blk < 128) {
    const int x = blk & 7, q = blk >> 3, chain = (x * 4 + (q >> 2)) & 31, vp = q & 3;
    const int dir = chain & 1, h = (chain >> 1) & 3, b = chain >> 3;
    unsigned char* r2 = F.ws + WS_R2;
    bf16* Od = (bf16*)(r2 + (dir ? R2_OB : R2_OF));
    LAS unsigned char* lds = F.lds + RING_OFF;
    const int lane = F.lane, qi = lane & 15, G = lane >> 4, w = F.wave;
    constexpr int PD = 6;
    if (w < 4) {
        f32x4 st[2][2] = {{{0.f, 0.f, 0.f, 0.f}, {0.f, 0.f, 0.f, 0.f}}, {{0.f, 0.f, 0.f, 0.f}, {0.f, 0.f, 0.f, 0.f}}};
        HSOps A, B, C, Dq;
        asm volatile("s_waitcnt vmcnt(0)" ::: "memory");
        hseq_load(A, r2, 0, b, h, dir, w, lane); hseq_load(B, r2, 1, b, h, dir, w, lane); hseq_load(C, r2, 2, b, h, dir, w, lane);
        HSEQ_BAR();
#pragma unroll 1
        for (int c = 0; c < 68; c += 4) {
            hseq_load(Dq, r2, c + 3, b, h, dir, w, lane);
            hseq_step(A, st, lds, c, w, lane, qi, G);
            if (c + 1 > 64) { HSEQ_BAR(); break; }
            hseq_load(A, r2, c + 4, b, h, dir, w, lane);
            hseq_step(B, st, lds, c + 1, w, lane, qi, G);
            hseq_load(B, r2, c + 5, b, h, dir, w, lane);
            hseq_step(C, st, lds, c + 2, w, lane, qi, G);
            hseq_load(C, r2, c + 6, b, h, dir, w, lane);
            hseq_step(Dq, st, lds, c + 3, w, lane, qi, G);
        }
        asm volatile("s_waitcnt vmcnt(0)" ::: "memory");
    } else {
        const int hw = w - 4;
        float* dummy = (float*)(r2 + R2_META + 2 * MiB) + ((size_t)blk * 4 + hw) * 512;
        asm volatile("s_waitcnt vmcnt(0)" ::: "memory");
#pragma unroll 1
        for (int c = -3; c < 0; ++c) hseq_helper(r2, Od, dummy, lds, c, PD, b, h, dir, vp, hw, lane);
        asm volatile("s_waitcnt vmcnt(0)" ::: "memory");
        HSEQ_BAR();
#pragma unroll 1
        for (int c = 0; c <= 65; ++c) {
            HSEQ_BAR();
            hseq_helper(r2, Od, dummy, lds, c, PD, b, h, dir, vp, hw, lane);
#if HS_WARM
            if (hw == 0) asm volatile("s_waitcnt vmcnt(14)" ::: "memory"); else if (hw == 1) asm volatile("s_waitcnt vmcnt(12)" ::: "memory"); else asm volatile("s_waitcnt vmcnt(10)" ::: "memory");
#else
            if (hw == 0) asm volatile("s_waitcnt vmcnt(8)" ::: "memory"); else asm volatile("s_waitcnt vmcnt(6)" ::: "memory");
#endif
        }
        asm volatile("s_waitcnt vmcnt(0)" ::: "memory");
    }
    }
    __syncthreads();
}

__device__ __forceinline__ void p4_combine(Frame& F) {
    const int gw = F.vcu * NWAVES + F.wave, NGW = F.G * NWAVES, lane = F.lane;
    const bf16* OF = (const bf16*)(F.ws + WS_R2 + R2_OF); const bf16* OB = (const bf16*)(F.ws + WS_R2 + R2_OB);
    const bf16* P = (const bf16*)(F.ws + WS_R1); bf16* Y = (bf16*)(F.ws + WS_Y); const float* gn = F.in[7];
    const f32x4 g0 = *(const GAS f32x4*)(gn + 8 * lane), g1 = *(const GAS f32x4*)(gn + 8 * lane + 4);
    for (int m = gw; m < M; m += NGW) {
        const int c0 = 8 * lane;
        const v4u af = *(const GAS v4u*)(OF + (size_t)m * 512 + c0), ab = *(const GAS v4u*)(OB + (size_t)m * 512 + c0);
        const v4u gt = *(const GAS v4u*)(P + (size_t)m * INC + C_GH + c0);
        const f32x4 o0 = {bflo(af.x) + bflo(ab.x), bfhi(af.x) + bfhi(ab.x), bflo(af.y) + bflo(ab.y), bfhi(af.y) + bfhi(ab.y)};
        const f32x4 o1 = {bflo(af.z) + bflo(ab.z), bfhi(af.z) + bfhi(ab.z), bflo(af.w) + bflo(ab.w), bfhi(af.w) + bfhi(ab.w)};
        float q = (o0.x * o0.x + o0.y * o0.y) + (o0.z * o0.z + o0.w * o0.w) + (o1.x * o1.x + o1.y * o1.y) + (o1.z * o1.z + o1.w * o1.w);
        q += __shfl_xor(q, 1); q += __shfl_xor(q, 2); q += __shfl_xor(q, 4); q += __shfl_xor(q, 8);
        const float rstd = __builtin_amdgcn_rsqf(q * (1.0f / 128.0f) + RMS_EPS);
        float gv[8] = {bflo(gt.x), bfhi(gt.x), bflo(gt.y), bfhi(gt.y), bflo(gt.z), bfhi(gt.z), bflo(gt.w), bfhi(gt.w)};
        float ov[8] = {o0.x * g0.x, o0.y * g0.y, o0.z * g0.z, o0.w * g0.w, o1.x * g1.x, o1.y * g1.y, o1.z * g1.z, o1.w * g1.w};
#pragma unroll
        for (int i = 0; i < 8; ++i) ov[i] = ov[i] * rstd * (gv[i] * sigmoidf_(gv[i]));
        v4u wv; wv.x = pk2(ov[0], ov[1]); wv.y = pk2(ov[2], ov[3]); wv.z = pk2(ov[4], ov[5]); wv.w = pk2(ov[6], ov[7]);
        *(GAS v4u*)(Y + (size_t)m * D + 512 + c0) = wv;
    }
}

__device__ __forceinline__ void p6_router(Frame& F, bool dry) {
    LAS float* lgs = (LAS float*)(F.lds + RING_OFF);
    LAS float* partL = lgs + 64 * 33;
    LAS float* rsL = partL + 8 * 64 * 36;
    LAS int* cntL = (LAS int*)(F.lds + TILE_E_OFF);
    LAS int* baseL = cntL + 32; LAS int* selE = cntL + 64; LAS int* selP = selE + 256; LAS float* selW = (LAS float*)(selP + 256);
    static_assert(TILE_E_OFF + (64 + 768) * 4 <= LDS_BYTES, "router LDS");
    static_assert((64 * 33 + 8 * 64 * 36 + 64) * 4 <= RING_BYTES, "router LDS (logits)");
    if (F.tid < 32) cntL[F.tid] = 0;
    __syncthreads();
    const bf16* HM = (const bf16*)(F.ws + WS_HMID); unsigned char* XN2 = F.ws + WS_XN2;
    const float* g2 = F.in[9]; const float* rb = F.in[11]; const bf16* WrT = (const bf16*)(F.ws + WS_WRT);
    const int lane = F.lane, qi = lane & 15, G = lane >> 4, w = F.wave;
    const float rbias = rb[F.tid & 31];
    for (int rb0 = F.vcu * 64; rb0 < M; rb0 += F.G * 64) {
        const bf16* xr = HM + (size_t)(rb0 + qi) * D + 128 * w + 8 * G;
        f32x4 acc[4][2];
#pragma unroll
        for (int mt = 0; mt < 4; ++mt) { acc[mt][0] = (f32x4){0.f, 0.f, 0.f, 0.f}; acc[mt][1] = (f32x4){0.f, 0.f, 0.f, 0.f}; }
        const bf16* wh0 = WrT + (size_t)qi * D + 128 * w + 8 * G; const bf16* wl0 = wh0 + NE * D;
        const float* gk = g2 + 128 * w + 8 * G;
        unsigned char* xo = XN2 + (size_t)(rb0 + qi) * D + 128 * w + 8 * G;
        float rs4[4] = {0.f, 0.f, 0.f, 0.f};
        v4u xq4[4][4];
#pragma unroll
        for (int ks = 0; ks < 4; ++ks)
#pragma unroll
            for (int mt = 0; mt < 4; ++mt) xq4[mt][ks] = *(const GAS v4u*)(xr + (size_t)(16 * mt) * D + 32 * ks);
#pragma unroll
        for (int tr = 0; tr < 2; ++tr) {
            f32x4 ga4[2], gb4[2]; bf16x8 bh4[2][2], bl4[2][2];
#pragma unroll
            for (int u = 0; u < 2; ++u) { const int ks = 2 * tr + u;
                ga4[u] = *(const GAS f32x4*)(gk + 32 * ks); gb4[u] = *(const GAS f32x4*)(gk + 32 * ks + 4);
#pragma unroll
                for (int nt = 0; nt < 2; ++nt) { bh4[u][nt] = *(const GAS bf16x8*)(wh0 + (size_t)nt * 16 * D + 32 * ks); bl4[u][nt] = *(const GAS bf16x8*)(wl0 + (size_t)nt * 16 * D + 32 * ks); } }
            __builtin_amdgcn_sched_barrier(0);
            if (tr == 0) {
                if (F.tid < 64) { const GAS f32x4* rp = (const GAS f32x4*)((const float*)(F.ws + WS_ROWSS) + (size_t)(rb0 + F.tid) * 16);
                    const f32x4 p0 = rp[0], p1 = rp[1], p2 = rp[2], p3 = rp[3];
                    const float ss = (((p0.x + p0.y) + (p0.z + p0.w)) + ((p1.x + p1.y) + (p1.z + p1.w))) + (((p2.x + p2.y) + (p2.z + p2.w)) + ((p3.x + p3.y) + (p3.z + p3.w)));
                    rsL[F.tid] = __builtin_amdgcn_rsqf(ss * (1.f / D) + RMS_EPS); }
                __syncthreads();
#pragma unroll
                for (int mt = 0; mt < 4; ++mt) rs4[mt] = rsL[16 * mt + qi];
            }
#pragma unroll
            for (int u = 0; u < 2; ++u) { const int ks = 2 * tr + u;
#pragma unroll
                for (int mt = 0; mt < 4; ++mt) {
                    const v4u xq = xq4[mt][ks]; const f32x4 xa0 = {bflo(xq.x), bfhi(xq.x), bflo(xq.y), bfhi(xq.y)}, xb0 = {bflo(xq.z), bfhi(xq.z), bflo(xq.w), bfhi(xq.w)};
                    const f32x4 xa = xa0 * rs4[mt] * ga4[u], xb = xb0 * rs4[mt] * gb4[u];
                    v4u hi, lo;
                    hi.x = cvtpk(xa.x, xa.y); hi.y = cvtpk(xa.z, xa.w); hi.z = cvtpk(xb.x, xb.y); hi.w = cvtpk(xb.z, xb.w);
                    lo.x = cvtpk(xa.x - bflo(hi.x), xa.y - bfhi(hi.x)); lo.y = cvtpk(xa.z - bflo(hi.y), xa.w - bfhi(hi.y)); lo.z = cvtpk(xb.x - bflo(hi.z), xb.y - bfhi(hi.z)); lo.w = cvtpk(xb.z - bflo(hi.w), xb.w - bfhi(hi.w));
                    const bf16x8 ah = __builtin_bit_cast(bf16x8, hi), al = __builtin_bit_cast(bf16x8, lo);
                    acc[mt][0] = mfma16(ah, bh4[u][0], acc[mt][0]); acc[mt][0] = mfma16(ah, bl4[u][0], acc[mt][0]); acc[mt][0] = mfma16(al, bh4[u][0], acc[mt][0]);
                    acc[mt][1] = mfma16(ah, bh4[u][1], acc[mt][1]); acc[mt][1] = mfma16(ah, bl4[u][1], acc[mt][1]); acc[mt][1] = mfma16(al, bh4[u][1], acc[mt][1]);
                    v2u o; o.x = pg8::pk4_fp8(xa.x, xa.y, xa.z, xa.w); o.y = pg8::pk4_fp8(xb.x, xb.y, xb.z, xb.w);
                    *(GAS v2u*)(xo + (size_t)(16 * mt) * D + 32 * ks) = o; } }
        }
        { LAS float* pw = partL + w * (64 * 36);
#pragma unroll
          for (int mt = 0; mt < 4; ++mt)
#pragma unroll
              for (int r = 0; r < 4; ++r) { pw[(16 * mt + 4 * G + r) * 36 + qi] = acc[mt][0][r]; pw[(16 * mt + 4 * G + r) * 36 + 16 + qi] = acc[mt][1][r]; } }
        __syncthreads();
#pragma unroll
        for (int i = 0; i < 4; ++i) { const int idx = F.tid + 512 * i, row = idx >> 5, e = idx & 31; float sm = rbias;
#pragma unroll
            for (int ww = 0; ww < 8; ++ww) sm += partL[ww * (64 * 36) + row * 36 + e];
            lgs[row * 33 + e] = sm; }
        __syncthreads();
        if (F.tid < 64) {
            float lg[32];
#pragma unroll
            for (int e = 0; e < 32; ++e) lg[e] = lgs[F.tid * 33 + e];
            int ti[4]; float tv[4];
#pragma unroll
            for (int t = 0; t < 4; ++t) { float best = -3.0e38f; int bi = 0;
#pragma unroll
                for (int e = 0; e < 32; ++e) { const bool tk = (t > 0 && ti[0] == e) || (t > 1 && ti[1] == e) || (t > 2 && ti[2] == e); if (!tk && lg[e] > best) { best = lg[e]; bi = e; } }
                ti[t] = bi; tv[t] = best; }
            const float p1 = __expf(tv[1] - tv[0]), p2 = __expf(tv[2] - tv[0]), p3 = __expf(tv[3] - tv[0]); const float inv = 1.0f / (1.0f + p1 + p2 + p3);
            const float wsm[4] = {inv, p1 * inv, p2 * inv, p3 * inv};
#pragma unroll
            for (int t = 0; t < 4; ++t) { const int lp = __hip_atomic_fetch_add(cntL + ti[t], 1, __ATOMIC_RELAXED, __HIP_MEMORY_SCOPE_WORKGROUP);
                selE[F.tid * 4 + t] = ti[t]; selP[F.tid * 4 + t] = lp; selW[F.tid * 4 + t] = wsm[t]; }
        }
        __syncthreads();
        if (F.tid < 32 && !dry) { const int n = cntL[F.tid]; baseL[F.tid] = n > 0 ? (int)__hip_atomic_fetch_add(F.ctl + CW_CNT + F.tid, (unsigned)n, RLX_AGENT) : 0; }
        __syncthreads();
        if (F.tid < 256 && !dry) { const int e = selE[F.tid], pos = baseL[e] + selP[F.tid]; const int tok4 = (rb0 + (F.tid >> 2)) * 4 + (F.tid & 3);
            ((unsigned*)(F.ws + WS_LIST))[(size_t)e * LCAP + pos] = (unsigned)tok4 | (pk2(selW[F.tid], selW[F.tid]) & 0xffff0000u); }
        __syncthreads();
        if (F.tid < 32) cntL[F.tid] = 0;
        __syncthreads();
    }
}

__device__ __forceinline__ int moe_table(Frame& F) {
    LAS int* tileE = (LAS int*)(F.lds + TILE_E_OFF); LAS int* rowbase = tileE + NTILE_MAX; LAS int* cntS = rowbase + 32; LAS int* ntS = cntS + 32; LAS int* endS = ntS + 2;
    static_assert((NTILE_MAX + 64 + 2 + 32) * 4 <= 2048, "MoE table stays below the conversion's batch word");
    if (F.tid < 64) { const int c = F.tid < NE ? (int)__hip_atomic_load(F.ctl + CW_CNT + (F.tid & 31), RLX_AGENT) : 0; const int t = (c + 255) >> 8; int inc = t;
#pragma unroll
        for (int o = 1; o < 32; o <<= 1) { const int v = __shfl_up(inc, o); if (F.lane >= o) inc += v; }
        if (F.tid < NE) { cntS[F.tid] = c; rowbase[F.tid] = (inc - t) * 256; endS[F.tid] = inc; }
        if (F.tid == NE - 1) ntS[0] = inc; }
    __syncthreads();
    const int NT = ntS[0];
    for (int tt = F.tid; tt < NT; tt += NWAVES * 64) { int e = 0;
#pragma unroll
        for (int k = 0; k < NE; ++k) e += endS[k] <= tt ? 1 : 0;
        tileE[tt] = e; }
    __syncthreads();
    return NT;
}

__device__ __forceinline__ void p9_final(Frame& F) {
    typedef float f32x2_t __attribute__((ext_vector_type(2)));
    const int gw = F.vcu * NWAVES + F.wave, NGW = F.G * NWAVES, lane = F.lane;
    const bf16* HM = (const bf16*)(F.ws + WS_HMID); const unsigned char* YS = F.ws + WS_R1; const float* gf = F.in[16];
    f32x4 gfv[4];
#pragma unroll
    for (int j = 0; j < 4; ++j) gfv[j] = *(const GAS f32x4*)(gf + 4 * lane + 256 * j);
    for (int m = gw; m < M; m += NGW) {
        f32x4 v[4]; float s = 0.f;
#pragma unroll
        for (int j = 0; j < 4; ++j) { f32x4 ya = {0.f, 0.f, 0.f, 0.f};
#pragma unroll
            for (int k = 0; k < 4; ++k) { const int y = *(const GAS int*)(YS + ((size_t)m * 4 + k) * D + 4 * lane + 256 * j);
                const f32x2_t lo = __builtin_amdgcn_cvt_pk_f32_fp8(y, false), hi = __builtin_amdgcn_cvt_pk_f32_fp8(y, true);
                ya.x += lo.x; ya.y += lo.y; ya.z += hi.x; ya.w += hi.y; }
            const v2u hq = *(const GAS v2u*)(HM + (size_t)m * D + 4 * lane + 256 * j); const f32x4 hv = {bflo(hq.x), bfhi(hq.x), bflo(hq.y), bfhi(hq.y)};
            v[j] = hv + ya * (1.0f / 8.0f);
            s += (v[j].x * v[j].x + v[j].y * v[j].y) + (v[j].z * v[j].z + v[j].w * v[j].w); }
        const float rstd = __builtin_amdgcn_rsqf(wave_sum(s) * (1.f / D) + RMS_EPS);
#pragma unroll
        for (int j = 0; j < 4; ++j) *(GAS f32x4*)(F.out + (size_t)m * D + 4 * lane + 256 * j) = v[j] * rstd * gfv[j];
    }
}

#ifndef PROBE_DUP
#define PROBE_DUP -1
#endif
struct Args { const float* in[17]; float* out; unsigned char* ws; int ph_lo, ph_hi, li, pad; };
__global__ void __launch_bounds__(NWAVES * 64, 2) hymba_fwd(Args args) {
    extern __shared__ __attribute__((aligned(16))) unsigned char lds[];
    Frame F;
    F.lds = (LAS unsigned char*)lds;
    F.MISC = (volatile LAS unsigned*)(F.lds + MISC_OFF);
    F.tid = threadIdx.x; F.lane = F.tid & 63; F.wave = __builtin_amdgcn_readfirstlane(F.tid >> 6);
    F.G = gridDim.x; { const int bx = blockIdx.x; F.vcu = (F.G % 8 == 0) ? (bx % 8) * (F.G / 8) + bx / 8 : bx; }
    F.ws = args.ws; F.ctl = (gu32*)(args.ws + WS_CTL); F.out = args.out;
#pragma unroll
    for (int i = 0; i < 17; ++i) F.in[i] = args.in[i];
    for (int u = F.tid; u < (LDS_BYTES - LDSCTL_OFF) / 4; u += NWAVES * 64) ((LAS unsigned*)(F.lds + LDSCTL_OFF))[u] = 0u;
    __syncthreads();
    XcdBarrier bar; bar.bar = (unsigned*)(F.ctl + CW_BAR); bar.x = 0; bar.st = nullptr;
    if (N_LAUNCHES == 1) bar = xcd_barrier_post((unsigned*)(F.ctl + CW_BAR), F.MISC + 8);
#define GRID_BAR() do { if (N_LAUNCHES == 1) { xcd_barrier(bar); if (PROBE_DUP == 99) xcd_barrier(bar); } } while (0)
    const int lo = args.ph_lo, hi = args.ph_hi;
#define IN(k) (lo <= (k) && (k) < hi)
#define BOTH(k) (IN(k) && IN((k) + 1))

#define REPS(k) ((PROBE_DUP == (k)) ? 2 : 1)
#define REPEAT(k, body) do { for (int rep_ = 0; rep_ < REPS(k); ++rep_) { body; if (rep_ + 1 < REPS(k)) GRID_BAR(); } } while (0)
    if (IN(0)) { REPEAT(0, p0_prologue(F)); if (BOTH(0)) GRID_BAR(); }
    if (IN(1)) {
        REPEAT(100, p1_meta_proj(F));
        for (int rep_ = 0; rep_ < REPS(1); ++rep_) {
        pg8::Gemm g{(const bf16*)(F.ws + WS_XN), (const bf16*)(F.ws + WS_WIN), M, INC, D}; pg8::StaticOrder S; S.init(M, INC, F.G, (int)blockIdx.x);
        pg8::EpiProj E{(bf16*)(F.ws + WS_R1)};
        pg8::gemm_phase<pg8::EpiProj, pg8::StaticOrder, true, true>(F.lds + RING_OFF, g, S, E);
        if (rep_ + 1 < REPS(1)) GRID_BAR(); }
        if (BOTH(1)) GRID_BAR();
    }
    if (IN(2)) { REPEAT(20, p2_natten(F)); REPEAT(21, p2_hprep(F)); if (BOTH(2)) GRID_BAR(); }
    if (IN(3)) { p3_hseq(F); if (PROBE_DUP == 3) { GRID_BAR(); p3_hseq(F); } p3_convert<false>(F, 0, 0); if (BOTH(3)) GRID_BAR(); }
    if (IN(4)) { REPEAT(4, p4_combine(F)); if (BOTH(4)) GRID_BAR(); }
    if (IN(5)) {
        { pg8::Gemm g{(const bf16*)(F.ws + WS_Y), (const bf16*)(F.ws + WS_WOUT), M, D, D}; pg8::StaticOrder S; S.init(M, D, F.G, (int)blockIdx.x);
          pg8::EpiResF32 E{F.in[0], (bf16*)(F.ws + WS_HMID), (float*)(F.ws + WS_ROWSS)};
          pg8::gemm_phase<pg8::EpiResF32, pg8::StaticOrder, false, true>(F.lds + RING_OFF, g, S, E); }
        if (PROBE_DUP == 5) { GRID_BAR();
          pg8::Gemm g{(const bf16*)(F.ws + WS_Y), (const bf16*)(F.ws + WS_WOUT), M, D, D}; pg8::StaticOrder S; S.init(M, D, F.G, (int)blockIdx.x);
          pg8::EpiResF32 E{F.in[0], (bf16*)(F.ws + WS_HMID), (float*)(F.ws + WS_ROWSS)};
          pg8::gemm_phase<pg8::EpiResF32, pg8::StaticOrder, false, true>(F.lds + RING_OFF, g, S, E); }
        if (BOTH(5)) GRID_BAR();
    }
    if (IN(6)) { p6_router(F, false); if (PROBE_DUP == 6) { GRID_BAR(); p6_router(F, true); } if (BOTH(6)) GRID_BAR(); }
    if (IN(8)) {
        const int NT = moe_table(F);
        for (int rep_ = 0; rep_ < REPS(8); ++rep_) {
        pg8::Gemm g{(const bf16*)(F.ws + WS_XN2), (const bf16*)(F.ws + WS_WGU), NT * 256, 2048, D}; pg8::MoeOrder S; S.init(NT, 8, F.G, (int)blockIdx.x, 2048, (const LAS int*)(F.lds + TILE_E_OFF), (const int*)(F.ws + WS_LIST), LCAP);
        pg8::EpiSwigluF8 E{F.ws + WS_R2, F.in[13]};
        pg8::gemm_phase<pg8::EpiSwigluF8, pg8::MoeOrder, true, true, true, true>(F.lds + RING_OFF, g, S, E);
        if (rep_ + 1 < REPS(8)) GRID_BAR(); }
        p3_convert<true>(F, 32, 1);
        if (BOTH(8)) GRID_BAR();
    }
    if (IN(9)) {
        const int NT = (N_LAUNCHES == 1 && IN(8)) ? ((const LAS int*)(F.lds + TILE_E_OFF))[NTILE_MAX + 64] : moe_table(F);
        for (int rep_ = 0; rep_ < REPS(9); ++rep_) {
        pg8::Gemm g{(const bf16*)(F.ws + WS_R2), (const bf16*)(F.ws + WS_WD), NT * 256, 1024, D}; pg8::MoeOrder S; S.init(NT, 4, F.G, (int)blockIdx.x, 1024, (const LAS int*)(F.lds + TILE_E_OFF), (const int*)(F.ws + WS_LIST), LCAP);
        pg8::EpiDown E{F.ws + WS_R1, F.in[15], &S};
        pg8::gemm_phase<pg8::EpiDown, pg8::MoeOrder, true, true, true>(F.lds + RING_OFF, g, S, E);
        if (rep_ + 1 < REPS(9)) GRID_BAR(); }
        if (BOTH(9)) GRID_BAR();
    }
    if (IN(10)) { REPEAT(10, p9_final(F)); }
#undef IN
#undef BOTH
}

extern "C" void kernel_launch(void* const* d_in, const int* in_sizes, int n_in, void* d_out, int out_size, void* d_ws, size_t ws_size, hipStream_t stream) {
    static int grid = 0;
    if (grid == 0) {
        if (n_in != 17 || in_sizes[0] != M * D || out_size != M * D || ws_size < WS_END) { fprintf(stderr, "kernel_launch: unexpected shapes (n_in %d, in0 %d, out %d, ws %zu); nothing launched\n", n_in, n_in > 0 ? in_sizes[0] : -1, out_size, ws_size); grid = -1; return; }
        int dev = 0, cus = 0, per_cu = 0;
        if (hipGetDevice(&dev) != hipSuccess || hipDeviceGetAttribute(&cus, hipDeviceAttributeMultiprocessorCount, dev) != hipSuccess) { grid = -1; return; }
        if (hipFuncSetAttribute((const void*)hymba_fwd, hipFuncAttributeMaxDynamicSharedMemorySize, LDS_BYTES) != hipSuccess) { fprintf(stderr, "kernel_launch: hipFuncSetAttribute failed\n"); grid = -1; return; }
        if (hipOccupancyMaxActiveBlocksPerMultiprocessor(&per_cu, (const void*)hymba_fwd, NWAVES * 64, LDS_BYTES) != hipSuccess || per_cu < 1)
            fprintf(stderr, "kernel_launch: note: occupancy query reports %d workgroups per CU\n", per_cu);
        (void)hipGetLastError();
        grid = cus;
        if (grid != 256) fprintf(stderr, "kernel_launch: note: %d CUs\n", grid);
    }
    if (grid < 0) return;
    if (hipMemsetAsync((char*)d_ws + WS_CTL, 0, CTL_ZERO_BYTES, stream) != hipSuccess) { fprintf(stderr, "kernel_launch: memset failed\n"); return; }
    Args a{};
    for (int i = 0; i < 17; ++i) a.in[i] = (const float*)d_in[i];
    a.out = (float*)d_out; a.ws = (unsigned char*)d_ws;
    if (N_LAUNCHES == 1) { a.ph_lo = 0; a.ph_hi = NPHASE; a.li = 0; hipLaunchKernelGGL(hymba_fwd, dim3(grid), dim3(NWAVES * 64), LDS_BYTES, stream, a); }
    else for (int li = 0; li < NPHASE; ++li) { a.ph_lo = li; a.ph_hi = li + 1; a.li = li; hipLaunchKernelGGL(hymba_fwd, dim3(grid), dim3(NWAVES * 64), LDS_BYTES, stream, a); }
    const hipError_t le = hipPeekAtLastError();
    if (le != hipSuccess) fprintf(stderr, "kernel_launch: launch failed: %s\n", hipGetErrorName(le));
}
```
